# Optimizing an MI355X kernel written in HIP

```python
import jax
import jax.numpy as jnp
from jax import lax
import numpy as np

D_MODEL = 1024
BATCH = 8
SEQ = 4096
DEPTH = 4

GRID_W = 64
HEAD_DIM = 64
LRU_BLOCKS = 6
LRU_BLOCK_DIM = 64
LRU_WIDTH = LRU_BLOCKS * LRU_BLOCK_DIM
RET_HEADS = 6
RET_WIDTH = RET_HEADS * HEAD_DIM
NA_HEADS = 4
NA_WIDTH = NA_HEADS * HEAD_DIM
MIX_WIDTH = LRU_WIDTH + RET_WIDTH + NA_WIDTH
IN_WIDTH = 2 * LRU_WIDTH + 4 * RET_WIDTH + 3 * NA_WIDTH
CONV_WIDTH = 4
LRU_C = 8.0
LRU_A_MIN = 0.9
LRU_A_MAX = 0.999
RET_CHUNK = 128
ROPE_BASE = 10000.0
GN_EPS = 1e-6
NA_MAX_KH = 8
NA_KW = 16
NA_QB = 16
NA_KS = NA_QB + NA_KW
D_FF = -(-8 * D_MODEL // (3 * 256)) * 256
DEEPNORM_ALPHA = (2 * DEPTH) ** 0.25
DEEPNORM_BETA = (8 * DEPTH) ** -0.25
LN_EPS = 1e-5

kernel_name = "hybrid_lru_retention_natten_deepnorm_encoder"


def _layer_norm(x, g, b):
    xf = x.astype(jnp.float32)
    mu = jnp.mean(xf, axis=-1, keepdims=True)
    xc = xf - mu
    var = jnp.mean(xc * xc, axis=-1, keepdims=True)
    y = xc * lax.rsqrt(var + LN_EPS) * g.astype(jnp.float32) + b.astype(jnp.float32)
    return y.astype(x.dtype)


def _linear_combine(c1, c2):
    a1, b1 = c1
    a2, b2 = c2
    return a1 * a2, a2 * b1 + b2


def _rg_lru_group(xb, gate, conv_w, conv_b, w_a, b_a, w_x, b_x, lam):
    bsz, seq, _ = xb.shape
    left = CONV_WIDTH // 2
    xp = jnp.pad(xb.astype(jnp.float32), ((0, 0), (left, CONV_WIDTH - 1 - left), (0, 0)))
    cw = conv_w.astype(jnp.float32)
    xc = conv_b.astype(jnp.float32)
    for j in range(CONV_WIDTH):
        xc = xc + xp[:, j:j + seq] * cw[j]
    xg = xc.reshape(bsz, seq, LRU_BLOCKS, LRU_BLOCK_DIM)
    h_sum = jnp.zeros_like(xc)
    for d, rev in enumerate((False, True)):
        r = jax.nn.sigmoid(jnp.einsum('bsgi,gij->bsgj', xg, w_a[d].astype(jnp.float32)).reshape(bsz, seq, LRU_WIDTH) + b_a[d].astype(jnp.float32))
        i = jax.nn.sigmoid(jnp.einsum('bsgi,gij->bsgj', xg, w_x[d].astype(jnp.float32)).reshape(bsz, seq, LRU_WIDTH) + b_x[d].astype(jnp.float32))
        log_a = -LRU_C * r * jax.nn.softplus(-lam[d].astype(jnp.float32))
        a = jnp.exp(log_a)
        u = jnp.sqrt(-jnp.expm1(2.0 * log_a)) * (i * xc)
        _, h = lax.associative_scan(_linear_combine, (a, u), axis=1, reverse=rev)
        h_sum = h_sum + h
    return (h_sum * jax.nn.gelu(gate.astype(jnp.float32))).astype(xb.dtype)


def _rope(t, pos):
    half = HEAD_DIM // 2
    inv_freq = ROPE_BASE ** (-jnp.arange(half, dtype=jnp.float32) / half)
    ang = pos[:, None] * inv_freq[None, :]
    cos = jnp.cos(ang)[None, :, None, :]
    sin = jnp.sin(ang)[None, :, None, :]
    t1, t2 = t[..., :half], t[..., half:]
    return jnp.concatenate([t1 * cos - t2 * sin, t1 * sin + t2 * cos], axis=-1)


def _retention_group(q, k, v, g, gn_w):
    bsz, seq, _ = q.shape
    C = RET_CHUNK
    nc = seq // C
    pos = jnp.arange(seq, dtype=jnp.float32)

    def heads(t):
        return t.astype(jnp.float32).reshape(bsz, seq, RET_HEADS, HEAD_DIM)

    def chunks(t):
        return t.transpose(0, 2, 1, 3).reshape(bsz, RET_HEADS, nc, C, HEAD_DIM)

    qc = chunks(_rope(heads(q), pos))
    kc = chunks(_rope(heads(k), pos) * HEAD_DIM ** -0.5)
    vc = chunks(heads(v))
    log_g = jnp.log1p(-jnp.exp2(-5.0 - jnp.arange(RET_HEADS, dtype=jnp.float32)))
    lg = log_g[:, None]
    idx = jnp.arange(C, dtype=jnp.float32)

    def bc(w):
        return w[:, None, :, None]

    decay = jnp.exp(jnp.abs(idx[:, None] - idx[None, :]) * log_g[:, None, None])
    s = jnp.einsum('bhnid,bhnjd->bhnij', qc, kc) * decay[:, None]
    o = jnp.einsum('bhnij,bhnjd->bhnid', s, vc)
    kv_f = jnp.einsum('bhnjd,bhnje->nbhde', kc * bc(jnp.exp((C - 1 - idx) * lg)), vc)
    kv_b = jnp.einsum('bhnjd,bhnje->nbhde', kc * bc(jnp.exp(idx * lg)), vc)
    g_chunk = jnp.exp(C * log_g)[:, None, None]

    def step(state, kv):
        return g_chunk * state + kv, state

    init = jnp.zeros((bsz, RET_HEADS, HEAD_DIM, HEAD_DIM), jnp.float32)
    _, st_f = lax.scan(step, init, kv_f)
    _, st_b = lax.scan(step, init, kv_b, reverse=True)
    o = (o
         + jnp.einsum('bhnid,nbhde->bhnie', qc * bc(jnp.exp((idx + 1.0) * lg)), st_f)
         + jnp.einsum('bhnid,nbhde->bhnie', qc * bc(jnp.exp((C - idx) * lg)), st_b))
    mu = jnp.mean(o, axis=-1, keepdims=True)
    oc = o - mu
    var = jnp.mean(oc * oc, axis=-1, keepdims=True)
    o = oc * lax.rsqrt(var + GN_EPS)
    o = o.reshape(bsz, RET_HEADS, seq, HEAD_DIM).transpose(0, 2, 1, 3).reshape(bsz, seq, RET_WIDTH)
    o = o * gn_w.astype(jnp.float32)
    return (jax.nn.silu(g.astype(jnp.float32)) * o).astype(q.dtype)


def _neighbourhood_attention_group(q, k, v, rpb):
    bsz, seq, _ = q.shape
    rows_n = seq // GRID_W
    kh = min(NA_MAX_KH, rows_n)
    nb = GRID_W // NA_QB
    rows = np.arange(rows_n)
    rstart = np.clip(rows - kh // 2, 0, rows_n - kh)
    row_idx = rstart[:, None] + np.arange(kh)
    dr = row_idx - rows[:, None]
    c0 = np.arange(nb) * NA_QB
    sstart = np.clip(c0 - NA_KW // 2, 0, GRID_W - NA_KS)
    col_idx = sstart[:, None] + np.arange(NA_KS)
    qcol = c0[:, None] + np.arange(NA_QB)
    cstart = np.clip(qcol - NA_KW // 2, 0, GRID_W - NA_KW)
    dc = col_idx[:, None, :] - qcol[:, :, None]
    valid = (col_idx[:, None, :] >= cstart[:, :, None]) & (col_idx[:, None, :] < cstart[:, :, None] + NA_KW)
    ri = (dr + NA_MAX_KH - 1)[:, None, None, :, None]
    ci = (np.clip(dc, 1 - NA_KW, NA_KW - 1) + NA_KW - 1)[None, :, :, None, :]
    bias = rpb.astype(jnp.float32)[:, ri, ci]
    bias = jnp.where(valid[None, None, :, :, None, :], bias, -jnp.inf)
    bias = bias.reshape(NA_HEADS, rows_n, nb, NA_QB, kh * NA_KS)

    def heads(t):
        return t.reshape(bsz, seq, NA_HEADS, HEAD_DIM).transpose(0, 2, 1, 3)

    qg = heads(q).reshape(bsz, NA_HEADS, rows_n, nb, NA_QB, HEAD_DIM)
    kgrid = heads(k).reshape(bsz, NA_HEADS, rows_n, GRID_W, HEAD_DIM)
    vgrid = heads(v).reshape(bsz, NA_HEADS, rows_n, GRID_W, HEAD_DIM)
    gr = row_idx[:, None, :, None]
    gc = col_idx[None, :, None, :]
    kb = kgrid[:, :, gr, gc].reshape(bsz, NA_HEADS, rows_n, nb, kh * NA_KS, HEAD_DIM)
    vb = vgrid[:, :, gr, gc].reshape(bsz, NA_HEADS, rows_n, nb, kh * NA_KS, HEAD_DIM)
    s = jnp.einsum('bhrnqd,bhrnkd->bhrnqk', qg, kb).astype(jnp.float32) * HEAD_DIM ** -0.5 + bias[None]
    p = jax.nn.softmax(s, axis=-1).astype(v.dtype)
    o = jnp.einsum('bhrnqk,bhrnkd->bhrnqd', p, vb)
    return o.reshape(bsz, NA_HEADS, seq, HEAD_DIM).transpose(0, 2, 1, 3).reshape(bsz, seq, NA_WIDTH)


def setup_inputs(seed: int = 0) -> dict:
    key = jax.random.key(seed)
    ks = jax.random.split(key, 20)

    def nrm(k, shape, scale):
        return jax.random.normal(k, shape, jnp.float32) * scale

    x = nrm(ks[0], (BATCH, SEQ, D_MODEL), 1.0)
    w_in = nrm(ks[1], (DEPTH, D_MODEL, IN_WIDTH), D_MODEL ** -0.5)
    conv_w = nrm(ks[2], (DEPTH, CONV_WIDTH, LRU_WIDTH), CONV_WIDTH ** -0.5)
    conv_b = nrm(ks[3], (DEPTH, LRU_WIDTH), 0.01)
    lru_w_a = nrm(ks[4], (DEPTH, 2, LRU_BLOCKS, LRU_BLOCK_DIM, LRU_BLOCK_DIM), LRU_BLOCK_DIM ** -0.5)
    lru_b_a = nrm(ks[5], (DEPTH, 2, LRU_WIDTH), 0.01)
    lru_w_x = nrm(ks[6], (DEPTH, 2, LRU_BLOCKS, LRU_BLOCK_DIM, LRU_BLOCK_DIM), LRU_BLOCK_DIM ** -0.5)
    lru_b_x = nrm(ks[7], (DEPTH, 2, LRU_WIDTH), 0.01)
    a_pow = jax.random.uniform(ks[8], (DEPTH, 2, LRU_WIDTH), jnp.float32, minval=LRU_A_MIN, maxval=LRU_A_MAX)
    a0 = a_pow ** (1.0 / LRU_C)
    lru_lam = jnp.log(a0) - jnp.log1p(-a0)
    ret_gn_w = 1.0 + nrm(ks[9], (DEPTH, RET_WIDTH), 0.02)
    na_rpb = nrm(ks[10], (DEPTH, NA_HEADS, 2 * NA_MAX_KH - 1, 2 * NA_KW - 1), 0.02)
    w_out = nrm(ks[11], (DEPTH, MIX_WIDTH, D_MODEL), MIX_WIDTH ** -0.5 * DEEPNORM_BETA)
    ln1_g = 1.0 + nrm(ks[12], (DEPTH, D_MODEL), 0.02)
    ln1_b = nrm(ks[13], (DEPTH, D_MODEL), 0.01)
    w_gate = nrm(ks[14], (DEPTH, D_MODEL, D_FF), D_MODEL ** -0.5)
    w_up = nrm(ks[15], (DEPTH, D_MODEL, D_FF), D_MODEL ** -0.5)
    w_down = nrm(ks[16], (DEPTH, D_FF, D_MODEL), D_FF ** -0.5 * DEEPNORM_BETA)
    ln2_g = 1.0 + nrm(ks[17], (DEPTH, D_MODEL), 0.02)
    ln2_b = nrm(ks[18], (DEPTH, D_MODEL), 0.01)
    return {'x': x, 'w_in': w_in, 'conv_w': conv_w, 'conv_b': conv_b,
            'lru_w_a': lru_w_a, 'lru_b_a': lru_b_a, 'lru_w_x': lru_w_x, 'lru_b_x': lru_b_x,
            'lru_lam': lru_lam, 'ret_gn_w': ret_gn_w, 'na_rpb': na_rpb, 'w_out': w_out,
            'ln1_g': ln1_g, 'ln1_b': ln1_b, 'w_gate': w_gate, 'w_up': w_up, 'w_down': w_down,
            'ln2_g': ln2_g, 'ln2_b': ln2_b}


def reference(x, w_in, conv_w, conv_b, lru_w_a, lru_b_a, lru_w_x, lru_b_x, lru_lam,
              ret_gn_w, na_rpb, w_out, ln1_g, ln1_b, w_gate, w_up, w_down, ln2_g, ln2_b):
    sizes = [LRU_WIDTH, LRU_WIDTH, RET_WIDTH, RET_WIDTH, RET_WIDTH, RET_WIDTH, NA_WIDTH, NA_WIDTH, NA_WIDTH]
    offsets = [int(o) for o in np.cumsum(sizes)[:-1]]
    for l in range(DEPTH):
        proj = x @ w_in[l]
        lru_x, lru_g, rq, rk, rv, rg, nq, nk, nv = jnp.split(proj, offsets, axis=-1)
        y_lru = _rg_lru_group(lru_x, lru_g, conv_w[l], conv_b[l], lru_w_a[l], lru_b_a[l],
                              lru_w_x[l], lru_b_x[l], lru_lam[l]).astype(proj.dtype)
        y_ret = _retention_group(rq, rk, rv, rg, ret_gn_w[l]).astype(proj.dtype)
        y_na = _neighbourhood_attention_group(nq, nk, nv, na_rpb[l]).astype(proj.dtype)
        mix = jnp.concatenate([y_lru, y_ret, y_na], axis=-1) @ w_out[l]
        x = _layer_norm(DEEPNORM_ALPHA * x + mix, ln1_g[l], ln1_b[l])
        hid = jax.nn.silu(x @ w_gate[l]) * (x @ w_up[l])
        x = _layer_norm(DEEPNORM_ALPHA * x + hid @ w_down[l], ln2_g[l], ln2_b[l])
    return x
```

```cpp
#include <hip/hip_runtime.h>
#include <hip/hip_cooperative_groups.h>
#include <cstdio>
namespace cg = cooperative_groups;
namespace pg8 {
#define PG8_LAS __attribute__((address_space(3)))
typedef unsigned short bf16_t;
typedef short bf16x8 __attribute__((ext_vector_type(8)));
typedef float f32x4 __attribute__((ext_vector_type(4)));
typedef unsigned u32x4 __attribute__((ext_vector_type(4)));
constexpr int BM = 256, BK = 64, HALF = 128, HTB = HALF * BK * 2  , STAGE_BYTES = 8 * HTB, NXCD = 8, WGM = 8;

__host__ __device__ __forceinline__ int lds_byte(int r, int c) { const int st = (r >> 4) * 2 + (c >> 5), rr = r & 15, cc = c & 31, ob = rr * 64 + cc * 2; return st * 1024 + (ob ^ (((ob >> 9) & 1) << 5)); }
__host__ __device__ __forceinline__ void stage_rc(int b, int& R, int& C) { const int st = b / 1024, sb = b % 1024, swz = sb ^ (((sb >> 9) & 1) << 5); R = (st >> 1) * 16 + swz / 64; C = (st & 1) * 32 + (swz % 64) / 2; }
__host__ __device__ __forceinline__ int perm32(int rho) { const int n = rho >> 4, i = rho & 15; return 8 * (i >> 2) + 4 * n + (i & 3); }

struct Unit { int pm, pn; };
struct Gemm { const bf16_t* A; const bf16_t* Bt; int M, N, K; };

struct StaticOrder {
    int nM, nN, nwg, G, c;
    __host__ __device__ void init(int M, int N, int G_, int c_) { nM = M / BM; nN = N / BM; nwg = nM * nN; G = G_; c = c_; }
    __host__ __device__ bool next(int i, Unit& u) const {
        const long L = (long)i * G + c; if (L >= nwg) return false;
        int wgid = (int)L; { const int q = nwg / NXCD, r = nwg % NXCD, xcd = wgid % NXCD, off = wgid / NXCD; wgid = (xcd < r ? xcd * (q + 1) : r * (q + 1) + (xcd - r) * q) + off; }
        const int nig = WGM * nN, gid = wgid / nig, fm = gid * WGM, gsz = (nM - fm) < WGM ? (nM - fm) : WGM;
        u.pm = fm + ((wgid % nig) % gsz); u.pn = (wgid % nig) / gsz; return true;
    }
    __device__ __forceinline__ void a_ready(const Unit&) const {}
    __device__ __forceinline__ void done(const Unit&) const {}
};
__device__ __forceinline__ unsigned cvt_pk_bf16(float lo, float hi) { unsigned r; asm volatile("v_cvt_pk_bf16_f32 %0, %1, %2" : "=v"(r) : "v"(lo), "v"(hi)); return r; }
template <class Epi, class Sched, bool STAMP = false>
__device__ __forceinline__ void gemm_phase(PG8_LAS unsigned char* lds, const Gemm g, const Sched& S, const Epi& E, unsigned long long* stamps) {
    int tid = threadIdx.x; asm volatile("" : "+v"(tid)); const int wid = __builtin_amdgcn_readfirstlane(tid >> 6), lane = tid & 63, wr = wid >> 2, wc = wid & 3, fr = lane & 15, fq = lane >> 4;
    const int K = g.K, nt = K / BK;
    int ts_lo = 0, ts_hi = 0, nts = 0; const unsigned long long rt_entry = STAMP ? (unsigned long long)wall_clock64() : 0ull;
#define PG8_STAMP() do { if (STAMP && wid == 0 && nts < 64) { const unsigned long long _c = (unsigned long long)clock64(); \
        ts_lo = (lane == nts) ? (int)(unsigned)_c : ts_lo; ts_hi = (lane == nts) ? (int)(unsigned)(_c >> 32) : ts_hi; ++nts; } } while (0)
    PG8_STAMP();
    unsigned voffA[2], voffB[2];
#pragma unroll
    for (int i = 0; i < 2; ++i) { int R, C; stage_rc(tid * 16 + i * 8192, R, C); const int Rb = Epi::PERM ? ((R & ~31) + perm32(R & 31)) : R;
        voffA[i] = (unsigned)(R * K + C) * 2u; voffB[i] = (unsigned)(Rb * K + C) * 2u; }
    const size_t kstep = (size_t)(BK * 2);
    const size_t hstep = (size_t)HALF * K * 2;
    const size_t tstep = 2 * hstep;
    const unsigned ldsw = (unsigned)wid * 1024u;
    const int aoff = lds_byte(wr * 64 + fr, fq * 8), boff = lds_byte(wc * 32 + fr, fq * 8);
#define PG8_SA(b, h) (((b) * 2 + (h)) * HTB)
#define PG8_SB(b, h) ((4 + (b) * 2 + (h)) * HTB)
#define PG8_STAGE(bufoff, gbase, voff) do { _Pragma("unroll") for (int _i = 0; _i < 2; ++_i) \
        __builtin_amdgcn_global_load_lds((const unsigned*)((const char*)(gbase) + (voff)[_i]), (PG8_LAS unsigned*)(lds + (bufoff) + ldsw + _i * 8192), 16, 0, 0); } while (0)
#define PG8_LDA(dst, b, h) do { _Pragma("unroll") for (int m = 0; m < 4; ++m) _Pragma("unroll") for (int k = 0; k < 2; ++k) dst[m][k] = *(const PG8_LAS bf16x8*)(lds + PG8_SA(b, h) + aoff + m * 2048 + k * 1024); } while (0)
#define PG8_LDB(dst, b, h) do { _Pragma("unroll") for (int n = 0; n < 2; ++n) _Pragma("unroll") for (int k = 0; k < 2; ++k) dst[n][k] = *(const PG8_LAS bf16x8*)(lds + PG8_SB(b, h) + boff + n * 2048 + k * 1024); } while (0)
#define PG8_MMA(ai, bj, At, Bt) do { __builtin_amdgcn_s_setprio(1); _Pragma("unroll") for (int m = 0; m < 4; ++m) _Pragma("unroll") for (int n = 0; n < 2; ++n) _Pragma("unroll") for (int k = 0; k < 2; ++k) \
        acc[ai][bj][m][n] = __builtin_amdgcn_mfma_f32_16x16x32_bf16(Bt[n][k], At[m][k], acc[ai][bj][m][n], 0, 0, 0); __builtin_amdgcn_s_setprio(0); } while (0)
#define PG8_WAIT_V(n) asm volatile("s_waitcnt vmcnt(" #n ")" ::: "memory")
#define PG8_WAIT_L(n) asm volatile("s_waitcnt lgkmcnt(" #n ")" ::: "memory")
#define PG8_BAR __builtin_amdgcn_s_barrier()
#define PG8_SCHED __builtin_amdgcn_sched_barrier(0)
    Unit cur, nxt; int ui = 0;
    if (!S.next(0, cur)) return;
    f32x4 acc[2][2][4][2];
#pragma unroll
    for (int a = 0; a < 2; ++a)
#pragma unroll
        for (int b = 0; b < 2; ++b)
#pragma unroll
            for (int m = 0; m < 4; ++m)
#pragma unroll
                for (int n = 0; n < 2; ++n) acc[a][b][m][n] = (f32x4){0.f, 0.f, 0.f, 0.f};
    bf16x8 At[4][2], B0[2][2], B1[2][2];
    const char* cA = (const char*)g.A + (size_t)cur.pm * tstep; const char* cB = (const char*)g.Bt + (size_t)cur.pn * tstep;
    S.a_ready(cur);
    PG8_STAGE(PG8_SB(0, 0), cB, voffB); PG8_STAGE(PG8_SA(0, 0), cA, voffA); PG8_STAGE(PG8_SB(0, 1), cB + hstep, voffB); PG8_STAGE(PG8_SA(0, 1), cA + hstep, voffA);
    if (wr == 1) PG8_BAR;
    PG8_WAIT_V(4); PG8_BAR;
    PG8_STAGE(PG8_SB(1, 0), cB + kstep, voffB); PG8_STAGE(PG8_SA(1, 0), cA + kstep, voffA); PG8_STAGE(PG8_SB(1, 1), cB + hstep + kstep, voffB);
    PG8_WAIT_V(6); PG8_BAR;
    PG8_STAMP();
    for (;;) {
        const bool has_next = S.next(ui + 1, nxt);
        const char* nA = has_next ? (const char*)g.A + (size_t)nxt.pm * tstep : cA; const char* nB = has_next ? (const char*)g.Bt + (size_t)nxt.pn * tstep : cB;
        for (int t = 0; t < nt; t += 2) {
            const bool last = (t == nt - 2);
            const char* a1 = cA + (size_t)(t + 1) * kstep;
            const char* a2 = last ? nA : cA + (size_t)(t + 2) * kstep; const char* b2 = last ? nB : cB + (size_t)(t + 2) * kstep;
            const char* a3 = a2 + kstep; const char* b3 = b2 + kstep;
            if (last && has_next) S.a_ready(nxt);
            PG8_LDB(B0, 0, 0); PG8_SCHED; PG8_LDA(At, 0, 0); PG8_STAGE(PG8_SA(1, 1), a1 + hstep, voffA);
            PG8_WAIT_L(8); PG8_BAR; PG8_WAIT_L(0); PG8_MMA(0, 0, At, B0); PG8_BAR; PG8_SCHED;
            PG8_LDB(B1, 0, 1); PG8_STAGE(PG8_SB(0, 0), b2, voffB);
            PG8_BAR; PG8_WAIT_L(0); PG8_MMA(0, 1, At, B1); PG8_BAR;
            PG8_LDA(At, 0, 1); PG8_STAGE(PG8_SA(0, 0), a2, voffA);
            PG8_BAR; PG8_WAIT_L(0); PG8_MMA(1, 0, At, B0); PG8_BAR; PG8_SCHED;
            PG8_STAGE(PG8_SB(0, 1), b2 + hstep, voffB);
            PG8_WAIT_V(6); PG8_BAR; PG8_MMA(1, 1, At, B1); PG8_BAR;
            PG8_LDB(B0, 1, 0); PG8_SCHED; PG8_LDA(At, 1, 0); PG8_STAGE(PG8_SA(0, 1), a2 + hstep, voffA);
            PG8_WAIT_L(8); PG8_BAR; PG8_WAIT_L(0); PG8_MMA(0, 0, At, B0); PG8_BAR; PG8_SCHED;
            PG8_LDB(B1, 1, 1); PG8_STAGE(PG8_SB(1, 0), b3, voffB);
            PG8_BAR; PG8_WAIT_L(0); PG8_MMA(0, 1, At, B1); PG8_BAR;
            PG8_LDA(At, 1, 1); PG8_STAGE(PG8_SA(1, 0), a3, voffA);
            PG8_BAR; PG8_WAIT_L(0); PG8_MMA(1, 0, At, B0); PG8_BAR; PG8_SCHED;
            PG8_STAGE(PG8_SB(1, 1), b3 + hstep, voffB);
            PG8_WAIT_V(6); PG8_BAR; PG8_MMA(1, 1, At, B1); PG8_BAR;
        }
        PG8_STAMP();
        if constexpr (!Epi::AFTER_DRAIN) { E(acc, cur, wr, wc, fr, fq); S.done(cur); }
        PG8_STAMP();
        if (!has_next) break;
#pragma unroll
        for (int a = 0; a < 2; ++a)
#pragma unroll
            for (int b = 0; b < 2; ++b)
#pragma unroll
                for (int m = 0; m < 4; ++m)
#pragma unroll
                    for (int n = 0; n < 2; ++n) acc[a][b][m][n] = (f32x4){0.f, 0.f, 0.f, 0.f};
        cur = nxt; cA = nA; cB = nB; ++ui;
    }
    PG8_WAIT_V(0);
    if (wr == 0) PG8_BAR;
    PG8_BAR;
    if constexpr (Epi::AFTER_DRAIN) { E.fused(acc, cur, wr, wc, fr, fq, lds, wid, lane); S.done(cur); }
    PG8_STAMP();
    if (STAMP && wid == 0) { stamps[lane] = lane < nts ? (((unsigned long long)(unsigned)ts_hi << 32) | (unsigned)ts_lo) : 0ull;
        if (lane == 62) stamps[62] = rt_entry; if (lane == 63) stamps[63] = (unsigned long long)wall_clock64(); }
#undef PG8_STAMP
#undef PG8_SA
#undef PG8_SB
#undef PG8_STAGE
#undef PG8_LDA
#undef PG8_LDB
#undef PG8_MMA
#undef PG8_WAIT_V
#undef PG8_WAIT_L
#undef PG8_BAR
#undef PG8_SCHED
}
}

using pg8::bf16_t; using pg8::bf16x8; using pg8::f32x4; using pg8::u32x4;
typedef unsigned u32x2 __attribute__((ext_vector_type(2)));
#define LAS __attribute__((address_space(3)))

constexpr int SEQ = 4096, MTOK = 32768, NL = 4;
constexpr float ALPHA = 1.681792830507429f;
constexpr int LDS_BYTES = 131072;
constexpr int NPHASE = 1 + 9 * NL;

constexpr size_t WS_WIN = 0;
constexpr size_t WS_WOUT = WS_WIN + (size_t)NL * 3072 * 1024 * 2;
constexpr size_t WS_WGU = WS_WOUT + (size_t)NL * 1024 * 1024 * 2;
constexpr size_t WS_WD = WS_WGU + (size_t)NL * 5632 * 1024 * 2;
constexpr size_t WS_LRUW = WS_WD + (size_t)NL * 1024 * 2816 * 2;
constexpr size_t WS_ROPE = WS_LRUW + (size_t)NL * 2 * 2 * 6 * 4096 * 2;
constexpr size_t WS_XB = WS_ROPE + (size_t)4096 * 32 * 8;
constexpr size_t WS_R1 = WS_XB + (size_t)MTOK * 1024 * 2;
constexpr size_t WS_R2 = WS_R1 + (size_t)MTOK * 3072 * 2;
constexpr size_t WS_Y = WS_R2;
constexpr size_t WS_KV = WS_Y + (size_t)MTOK * 1024 * 2;
constexpr size_t WS_ST = WS_KV + (size_t)1536 * 2 * 4096 * 4;
constexpr size_t WS_R2END = WS_ST + (size_t)1536 * 2 * 4096 * 2;
constexpr size_t WS_AGG = WS_R2END;
constexpr size_t WS_CARRY = WS_AGG + (size_t)8 * 64 * 2 * 384 * 8;
constexpr size_t WS_END = WS_CARRY + (size_t)8 * 64 * 2 * 384 * 4;
static_assert(WS_R2END - WS_R2 >= (size_t)MTOK * 1024 * 4, "v2 alias");

#ifndef PHM
#define PHM 511
#endif
__device__ __forceinline__ int tidx() { int t = threadIdx.x; asm volatile("" : "+v"(t)); return t; }
__device__ __forceinline__ int bidx() { int b = blockIdx.x; asm volatile("" : "+s"(b)); return b; }
struct Params { const float* in[19]; float* out; unsigned char* ws; int ph_lo, ph_hi, coop, pad; };

__device__ __forceinline__ float bflo(unsigned w) { return __uint_as_float(w << 16); }
__device__ __forceinline__ float bfhi(unsigned w) { return __uint_as_float(w & 0xffff0000u); }
#define BFEL(v, jj) (((jj) & 1) ? bfhi((v)[(jj) >> 1]) : bflo((v)[(jj) >> 1]))
__device__ __forceinline__ unsigned pk(float lo, float hi) { return pg8::cvt_pk_bf16(lo, hi); }
__device__ __forceinline__ unsigned short f2bf(float f) { return (unsigned short)(pk(f, 0.f) & 0xffffu); }
__device__ __forceinline__ bf16x8 as_frag(u32x4 v) { return __builtin_bit_cast(bf16x8, v); }
__device__ __forceinline__ f32x4 mfma16(bf16x8 a, bf16x8 b, f32x4 c) { return __builtin_amdgcn_mfma_f32_16x16x32_bf16(a, b, c, 0, 0, 0); }
__device__ __forceinline__ float sigm(float x) { return 1.0f / (1.0f + __expf(-x)); }
__device__ __forceinline__ float log2gamma(int h) {
    return h == 0 ? -0.04580368961312479f : h == 1 ? -0.02272007650008353f : h == 2 ? -0.011315313227834146f
         : h == 3 ? -0.005646563141142063f : h == 4 ? -0.0028205190623786626f : -0.0014095702546713536f;
}
__device__ __forceinline__ int clampi(int v, int lo, int hi) { return v < lo ? lo : (v > hi ? hi : v); }

struct EpiProj {
    static constexpr bool PERM = true, AFTER_DRAIN = false;
    bf16_t* O;
    __device__ __forceinline__ void operator()(const f32x4 (&acc)[2][2][4][2], const pg8::Unit& u, int wr, int wc, int fr, int fq) const {
        const int row0 = u.pm * 256 + wr * 64 + fr, col0 = u.pn * 256 + wc * 32 + 8 * fq;
#pragma unroll
        for (int ai = 0; ai < 2; ++ai)
#pragma unroll
            for (int m = 0; m < 4; ++m) { bf16_t* rowp = O + (size_t)(row0 + ai * 128 + m * 16) * 3072 + col0;
#pragma unroll
                for (int bj = 0; bj < 2; ++bj) { const f32x4 v0 = acc[ai][bj][m][0], v1 = acc[ai][bj][m][1];
                    u32x4 w; w.x = pk(v0[0], v0[1]); w.y = pk(v0[2], v0[3]); w.z = pk(v1[0], v1[1]); w.w = pk(v1[2], v1[3]);
                    *(u32x4*)(rowp + bj * 128) = w; } }
    }
};
struct EpiResid {
    static constexpr bool PERM = false, AFTER_DRAIN = false;
    const float* base; float* out;
    __device__ __forceinline__ void operator()(const f32x4 (&acc)[2][2][4][2], const pg8::Unit& u, int wr, int wc, int fr, int fq) const {
        const int row0 = u.pm * 256 + wr * 64 + fr, col0 = u.pn * 256 + wc * 32 + 4 * fq;
#pragma unroll
        for (int ai = 0; ai < 2; ++ai)
#pragma unroll
            for (int m = 0; m < 4; ++m) { const size_t off = (size_t)(row0 + ai * 128 + m * 16) * 1024 + col0;
#pragma unroll
                for (int bj = 0; bj < 2; ++bj)
#pragma unroll
                    for (int n = 0; n < 2; ++n) { const f32x4 b = *(const f32x4*)(base + off + bj * 128 + n * 16);
                        *(f32x4*)(out + off + bj * 128 + n * 16) = b * ALPHA + acc[ai][bj][m][n]; }
                asm volatile("" ::: "memory"); }
    }
};
struct EpiSwiglu {
    static constexpr bool PERM = false, AFTER_DRAIN = false;
    bf16_t* H;
    __device__ __forceinline__ void operator()(const f32x4 (&acc)[2][2][4][2], const pg8::Unit& u, int wr, int wc, int fr, int fq) const {
        const int row0 = u.pm * 256 + wr * 64 + fr, h0 = u.pn * 128 + wc * 16 + 4 * fq;
#pragma unroll
        for (int ai = 0; ai < 2; ++ai)
#pragma unroll
            for (int m = 0; m < 4; ++m) { bf16_t* rowp = H + (size_t)(row0 + ai * 128 + m * 16) * 2816 + h0;
#pragma unroll
                for (int bj = 0; bj < 2; ++bj) { const f32x4 g = acc[ai][bj][m][0], uu = acc[ai][bj][m][1]; float hv[4];
#pragma unroll
                    for (int e = 0; e < 4; ++e) hv[e] = g[e] * sigm(g[e]) * uu[e];
                    u32x2 w; w.x = pk(hv[0], hv[1]); w.y = pk(hv[2], hv[3]);
                    *(u32x2*)(rowp + bj * 64) = w; } }
    }
};

__device__ void phase_init(const Params& p, unsigned char* ldsg) {
    const int tid = tidx(), nb = gridDim.x, bid = bidx();
    float* tile = (float*)ldsg;
    unsigned char* ws = p.ws;
    for (int T = bid; T < 12544; T += nb) {
        const int l = T / 3136; int r = T % 3136;
        const float* src; int ldsrc, lddst, k0, n0, mode = 0; bf16_t* dst;
        if (r < 768) { src = p.in[1] + (size_t)l * 1024 * 3072; ldsrc = 3072; dst = (bf16_t*)(ws + WS_WIN) + (size_t)l * 3072 * 1024; lddst = 1024; k0 = (r / 48) * 64; n0 = (r % 48) * 64; }
        else if (r < 1024) { r -= 768; src = p.in[11] + (size_t)l * 1024 * 1024; ldsrc = 1024; dst = (bf16_t*)(ws + WS_WOUT) + (size_t)l * 1024 * 1024; lddst = 1024; k0 = (r / 16) * 64; n0 = (r % 16) * 64; }
        else if (r < 1728) { r -= 1024; src = p.in[14] + (size_t)l * 1024 * 2816; ldsrc = 2816; dst = (bf16_t*)(ws + WS_WGU) + (size_t)l * 5632 * 1024; lddst = 1024; k0 = (r / 44) * 64; n0 = (r % 44) * 64; mode = 1; }
        else if (r < 2432) { r -= 1728; src = p.in[15] + (size_t)l * 1024 * 2816; ldsrc = 2816; dst = (bf16_t*)(ws + WS_WGU) + (size_t)l * 5632 * 1024; lddst = 1024; k0 = (r / 44) * 64; n0 = (r % 44) * 64; mode = 2; }
        else { r -= 2432; src = p.in[16] + (size_t)l * 2816 * 1024; ldsrc = 1024; dst = (bf16_t*)(ws + WS_WD) + (size_t)l * 1024 * 2816; lddst = 2816; k0 = (r / 16) * 64; n0 = (r % 16) * 64; }
#pragma unroll
        for (int i = 0; i < 2; ++i) { const int k = (tid >> 4) + 32 * i, n4 = (tid & 15) * 4;
            const float4 v = *(const float4*)(src + (size_t)(k0 + k) * ldsrc + n0 + n4);
            tile[k * 65 + n4 + 0] = v.x; tile[k * 65 + n4 + 1] = v.y; tile[k * 65 + n4 + 2] = v.z; tile[k * 65 + n4 + 3] = v.w; }
        __syncthreads();
        { const int n = tid >> 3, k8 = (tid & 7) * 8; float f[8];
#pragma unroll
            for (int j = 0; j < 8; ++j) f[j] = tile[(k8 + j) * 65 + n];
            const int ng = n0 + n; int drow = ng;
            if (mode == 1) drow = (ng >> 4) * 32 + (ng & 15); else if (mode == 2) drow = (ng >> 4) * 32 + 16 + (ng & 15);
            u32x4 w; w.x = pk(f[0], f[1]); w.y = pk(f[2], f[3]); w.z = pk(f[4], f[5]); w.w = pk(f[6], f[7]);
            *(u32x4*)(dst + (size_t)drow * lddst + k0 + k8) = w; }
        __syncthreads();
    }
    const int gt = bid * 512 + tid, gn = nb * 512;
    { const float* x = p.in[0]; bf16_t* xb = (bf16_t*)(ws + WS_XB);
      for (int i = gt; i < MTOK * 1024 / 8; i += gn) { const float4 a = *(const float4*)(x + (size_t)i * 8), b = *(const float4*)(x + (size_t)i * 8 + 4);
          u32x4 w; w.x = pk(a.x, a.y); w.y = pk(a.z, a.w); w.z = pk(b.x, b.y); w.w = pk(b.z, b.w); *(u32x4*)(xb + (size_t)i * 8) = w; } }
    { float2* rope = (float2*)(ws + WS_ROPE);
      for (int idx = gt; idx < 4096 * 32; idx += gn) { const int pos = idx >> 5, i = idx & 31;
          double f = 1.0; for (int k = 0; k < i; ++k) f *= 0.7498942093324559;
          const float inv = (float)f; const float ang = (float)pos * inv;
          const double a = (double)ang; const double nrev = rint(a * 0.15915494309189535); const double rr = (a - nrev * 6.283185307179586) * 0.25;
          const double r2 = rr * rr;
          double s = rr * (1.0 + r2 * (-1.0 / 6 + r2 * (1.0 / 120 + r2 * (-1.0 / 5040 + r2 * (1.0 / 362880 + r2 * (-1.0 / 39916800))))));
          double c = 1.0 + r2 * (-0.5 + r2 * (1.0 / 24 + r2 * (-1.0 / 720 + r2 * (1.0 / 40320 + r2 * (-1.0 / 3628800 + r2 * (1.0 / 479001600))))));
          double s2 = 2 * s * c, c2 = c * c - s * s; s = 2 * s2 * c2; c = c2 * c2 - s2 * s2;
          rope[idx] = make_float2((float)c, (float)s); } }
    { bf16_t* wt = (bf16_t*)(ws + WS_LRUW);
      for (int idx = gt; idx < NL * 2 * 2 * 6 * 64 * 8; idx += gn) { const int c8 = idx & 7, o = (idx >> 3) & 63, mat = idx >> 9;
          const int g = mat % 6, kind = (mat / 6) & 1, dir = (mat / 12) & 1, l = mat / 24;
          const float* src = (kind ? p.in[6] : p.in[4]) + ((size_t)((l * 2 + dir) * 6 + g) * 64 + c8 * 8) * 64 + o; float f[8];
#pragma unroll
          for (int j = 0; j < 8; ++j) f[j] = src[j * 64];
          u32x4 w; w.x = pk(f[0], f[1]); w.y = pk(f[2], f[3]); w.z = pk(f[4], f[5]); w.w = pk(f[6], f[7]);
          *(u32x4*)(wt + (size_t)mat * 4096 + o * 64 + c8 * 8) = w; } }
}

__device__ void phase_ln(const float* v, const float* g, const float* bta, float* xo, bf16_t* xb) {
    const int lane = tidx() & 63, wid = tidx() >> 6;
    float4 gg[4], bb[4];
#pragma unroll
    for (int i = 0; i < 4; ++i) { gg[i] = ((const float4*)g)[lane + 64 * i]; bb[i] = ((const float4*)bta)[lane + 64 * i]; }
    for (int row = bidx() * 8 + wid; row < MTOK; row += gridDim.x * 8) {
        const float4* pr = (const float4*)(v + (size_t)row * 1024); float4 a[4]; float s = 0.f;
#pragma unroll
        for (int i = 0; i < 4; ++i) { a[i] = pr[lane + 64 * i]; s += (a[i].x + a[i].y) + (a[i].z + a[i].w); }
#pragma unroll
        for (int o = 32; o >= 1; o >>= 1) s += __shfl_xor(s, o);
        const float mu = s * (1.0f / 1024.0f); float q = 0.f;
#pragma unroll
        for (int i = 0; i < 4; ++i) { a[i].x -= mu; a[i].y -= mu; a[i].z -= mu; a[i].w -= mu; q += (a[i].x * a[i].x + a[i].y * a[i].y) + (a[i].z * a[i].z + a[i].w * a[i].w); }
#pragma unroll
        for (int o = 32; o >= 1; o >>= 1) q += __shfl_xor(q, o);
        const float rstd = rsqrtf(q * (1.0f / 1024.0f) + 1e-5f);
#pragma unroll
        for (int i = 0; i < 4; ++i) { float4 y; y.x = a[i].x * rstd * gg[i].x + bb[i].x; y.y = a[i].y * rstd * gg[i].y + bb[i].y; y.z = a[i].z * rstd * gg[i].z + bb[i].z; y.w = a[i].w * rstd * gg[i].w + bb[i].w;
            ((float4*)(xo + (size_t)row * 1024))[lane + 64 * i] = y;
            u32x2 w; w.x = pk(y.x, y.y); w.y = pk(y.z, y.w); *(u32x2*)(xb + (size_t)row * 1024 + (lane + 64 * i) * 4) = w; }
    }
}

constexpr int VT_NA = 584;
__device__ void natten_item(const bf16_t* proj, bf16_t* y, int item, unsigned char* ldsg) {
    const int tid = tidx(), wid = tid >> 6, lane = tid & 63, fr = lane & 15, fq = lane >> 4;
    const int rp = item & 31, h = (item >> 5) & 3, b = item >> 7;
    bf16_t* Vt = (bf16_t*)ldsg; const float* rpb = (const float*)(ldsg + 75776) + h * 465;
    const int r0 = 2 * rp, rs0 = clampi(r0 - 4, 0, 56), rs1 = clampi(r0 - 3, 0, 56), rbase = rs0, nrows = rs1 + 8 - rbase;
    { const bf16_t* vbase = proj + ((size_t)b * 4096 + rbase * 64) * 3072 + 2816 + h * 64;
      for (int idx = tid; idx < nrows * 64 * 8; idx += 512) { const int key = idx >> 3, ds = idx & 7;
          const u32x4 v = *(const u32x4*)(vbase + (size_t)key * 3072 + ds * 8);
#pragma unroll
          for (int j = 0; j < 8; ++j) Vt[(ds * 8 + j) * VT_NA + key] = (unsigned short)((j & 1) ? (v[j >> 1] >> 16) : (v[j >> 1] & 0xffffu)); } }
    __syncthreads();
    {
        const int rsel = wid >> 2, n = wid & 3, r = r0 + rsel, rs = rsel ? rs1 : rs0, c0 = n * 16, ss = clampi(c0 - 8, 0, 32);
        const bf16_t* qp = proj + ((size_t)b * 4096 + r * 64 + c0 + fr) * 3072 + 2304 + h * 64 + fq * 8;
        const bf16x8 q0 = *(const bf16x8*)qp, q1 = *(const bf16x8*)(qp + 32);
        f32x4 s[8][2];
#pragma unroll
        for (int kr = 0; kr < 8; ++kr)
#pragma unroll
            for (int t = 0; t < 2; ++t) { const int kcol = ss + (fr >> 2) * 8 + 4 * t + (fr & 3);
                const bf16_t* kp = proj + ((size_t)b * 4096 + (rs + kr) * 64 + kcol) * 3072 + 2560 + h * 64 + fq * 8;
                const bf16x8 k0 = *(const bf16x8*)kp, k1 = *(const bf16x8*)(kp + 32);
                f32x4 a = {0.f, 0.f, 0.f, 0.f}; a = mfma16(k0, q0, a); a = mfma16(k1, q1, a); s[kr][t] = a; }
        const int qc = c0 + fr, cst = clampi(qc - 8, 0, 48);
        float mx = -3.0e38f;
#pragma unroll
        for (int kr = 0; kr < 8; ++kr) { const int ri = rs + kr - r + 7;
#pragma unroll
            for (int t = 0; t < 2; ++t)
#pragma unroll
                for (int e = 0; e < 4; ++e) { const int kc = ss + fq * 8 + 4 * t + e; const bool valid = (kc >= cst) && (kc < cst + 16);
                    const int ci = clampi(kc - qc, -15, 15) + 15;
                    const float v = valid ? s[kr][t][e] * 0.125f + rpb[ri * 31 + ci] : -3.0e38f; s[kr][t][e] = v; mx = fmaxf(mx, v); } }
        mx = fmaxf(mx, __shfl_xor(mx, 16)); mx = fmaxf(mx, __shfl_xor(mx, 32));
        float sum = 0.f;
#pragma unroll
        for (int kr = 0; kr < 8; ++kr)
#pragma unroll
            for (int t = 0; t < 2; ++t)
#pragma unroll
                for (int e = 0; e < 4; ++e) { const float v = s[kr][t][e]; const float pe = (v > -1.0e38f) ? __expf(v - mx) : 0.f; s[kr][t][e] = pe; sum += pe; }
        sum += __shfl_xor(sum, 16); sum += __shfl_xor(sum, 32);
        const float inv = 1.0f / sum;
        f32x4 o[4];
#pragma unroll
        for (int dt = 0; dt < 4; ++dt) o[dt] = (f32x4){0.f, 0.f, 0.f, 0.f};
#pragma unroll
        for (int kr = 0; kr < 8; ++kr) { u32x4 pw; pw.x = pk(s[kr][0][0] * inv, s[kr][0][1] * inv); pw.y = pk(s[kr][0][2] * inv, s[kr][0][3] * inv);
            pw.z = pk(s[kr][1][0] * inv, s[kr][1][1] * inv); pw.w = pk(s[kr][1][2] * inv, s[kr][1][3] * inv); const bf16x8 pf = as_frag(pw);
            const int koff = (rs + kr - rbase) * 64 + ss + fq * 8;
#pragma unroll
            for (int dt = 0; dt < 4; ++dt) { const bf16x8 vf = *(const bf16x8*)(Vt + (dt * 16 + fr) * VT_NA + koff); o[dt] = mfma16(vf, pf, o[dt]); } }
        bf16_t* yp = y + ((size_t)b * 4096 + r * 64 + c0 + fr) * 1024 + 768 + h * 64 + fq * 4;
#pragma unroll
        for (int dt = 0; dt < 4; ++dt) { u32x2 w; w.x = pk(o[dt][0], o[dt][1]); w.y = pk(o[dt][2], o[dt][3]); *(u32x2*)(yp + dt * 16) = w; }
    }
    __syncthreads();
}

constexpr int QS = 72, VS = 136;
__device__ void ret_a_item(const bf16_t* proj, const float2* rope, float* kv, int item, unsigned char* ldsg) {
    const int tid = tidx(), wid = tid >> 6, lane = tid & 63, fr = lane & 15, fq = lane >> 4;
    const int n = item & 31, h = (item >> 5) % 6, b = item / 192;
    bf16_t* Ktf = (bf16_t*)ldsg; bf16_t* Ktb = Ktf + 64 * VS; bf16_t* Vt = Ktb + 64 * VS;
    const float l2g = log2gamma(h);
    { const int j = tid >> 2, ds = tid & 3, pos = n * 128 + j; const size_t tok = (size_t)b * 4096 + pos;
      const bf16_t* kp = proj + tok * 3072 + 1152 + h * 64 + ds * 8;
      const u32x4 klo = *(const u32x4*)kp, khi = *(const u32x4*)(kp + 32);
      const float4* cs = (const float4*)(rope + pos * 32 + ds * 8);
      const float wf = exp2f((float)(127 - j) * l2g) * 0.125f, wb = exp2f((float)j * l2g) * 0.125f;
#pragma unroll
      for (int jp = 0; jp < 4; ++jp) { const float4 c4 = cs[jp];
#pragma unroll
          for (int hh = 0; hh < 2; ++hh) { const int jj = jp * 2 + hh; const float c = hh ? c4.z : c4.x, sn = hh ? c4.w : c4.y;
              const float t1 = BFEL(klo, jj), t2 = BFEL(khi, jj); const float o1 = t1 * c - t2 * sn, o2 = t1 * sn + t2 * c;
              Ktf[(ds * 8 + jj) * VS + j] = f2bf(o1 * wf); Ktf[(32 + ds * 8 + jj) * VS + j] = f2bf(o2 * wf);
              Ktb[(ds * 8 + jj) * VS + j] = f2bf(o1 * wb); Ktb[(32 + ds * 8 + jj) * VS + j] = f2bf(o2 * wb); } }
      const bf16_t* vp = proj + tok * 3072 + 1536 + h * 64 + ds * 16;
#pragma unroll
      for (int hv = 0; hv < 2; ++hv) { const u32x4 v = *(const u32x4*)(vp + hv * 8);
#pragma unroll
          for (int jj = 0; jj < 8; ++jj) Vt[(ds * 16 + hv * 8 + jj) * VS + j] = (unsigned short)((jj & 1) ? (v[jj >> 1] >> 16) : (v[jj >> 1] & 0xffffu)); } }
    __syncthreads();
    { const int et = wid >> 1;
#pragma unroll
      for (int dd = 0; dd < 2; ++dd) { const int dt = (wid & 1) * 2 + dd; f32x4 af = {0.f, 0.f, 0.f, 0.f}, ab = {0.f, 0.f, 0.f, 0.f};
#pragma unroll
          for (int js = 0; js < 4; ++js) { const bf16x8 A = *(const bf16x8*)(Vt + (et * 16 + fr) * VS + js * 32 + fq * 8);
              const bf16x8 Bf = *(const bf16x8*)(Ktf + (dt * 16 + fr) * VS + js * 32 + fq * 8), Bb = *(const bf16x8*)(Ktb + (dt * 16 + fr) * VS + js * 32 + fq * 8);
              af = mfma16(A, Bf, af); ab = mfma16(A, Bb, ab); }
          float* o = kv + (size_t)item * 2 * 4096 + (et * 16 + fq * 4) * 64 + dt * 16 + fr;
#pragma unroll
          for (int x = 0; x < 4; ++x) { o[x * 64] = af[x]; o[4096 + x * 64] = ab[x]; } } }
    __syncthreads();
}
__device__ void ret_c_item(const bf16_t* proj, const float2* rope, const bf16_t* st, const float* gnw, bf16_t* y, int item, unsigned char* ldsg) {
    const int tid = tidx(), wid = tid >> 6, lane = tid & 63, fr = lane & 15, fq = lane >> 4;
    const int n = item & 31, h = (item >> 5) % 6, b = item / 192;
    bf16_t* Qr = (bf16_t*)ldsg; bf16_t* Kr = Qr + 128 * QS; bf16_t* Vt = Kr + 128 * QS;
    const float l2g = log2gamma(h);
    { const int j = tid >> 2, ds = tid & 3, pos = n * 128 + j; const size_t tok = (size_t)b * 4096 + pos;
      const bf16_t* qp = proj + tok * 3072 + 768 + h * 64 + ds * 8; const bf16_t* kp = qp + 384;
      const u32x4 qlo = *(const u32x4*)qp, qhi = *(const u32x4*)(qp + 32), klo = *(const u32x4*)kp, khi = *(const u32x4*)(kp + 32);
      const float4* cs = (const float4*)(rope + pos * 32 + ds * 8);
      float q1[8], q2[8], k1[8], k2[8];
#pragma unroll
      for (int jp = 0; jp < 4; ++jp) { const float4 c4 = cs[jp];
#pragma unroll
          for (int hh = 0; hh < 2; ++hh) { const int jj = jp * 2 + hh; const float c = hh ? c4.z : c4.x, sn = hh ? c4.w : c4.y;
              float t1 = BFEL(qlo, jj), t2 = BFEL(qhi, jj); q1[jj] = t1 * c - t2 * sn; q2[jj] = t1 * sn + t2 * c;
              t1 = BFEL(klo, jj); t2 = BFEL(khi, jj); k1[jj] = (t1 * c - t2 * sn) * 0.125f; k2[jj] = (t1 * sn + t2 * c) * 0.125f; } }
      u32x4 w; w.x = pk(q1[0], q1[1]); w.y = pk(q1[2], q1[3]); w.z = pk(q1[4], q1[5]); w.w = pk(q1[6], q1[7]); *(u32x4*)(Qr + j * QS + ds * 8) = w;
      w.x = pk(q2[0], q2[1]); w.y = pk(q2[2], q2[3]); w.z = pk(q2[4], q2[5]); w.w = pk(q2[6], q2[7]); *(u32x4*)(Qr + j * QS + 32 + ds * 8) = w;
      w.x = pk(k1[0], k1[1]); w.y = pk(k1[2], k1[3]); w.z = pk(k1[4], k1[5]); w.w = pk(k1[6], k1[7]); *(u32x4*)(Kr + j * QS + ds * 8) = w;
      w.x = pk(k2[0], k2[1]); w.y = pk(k2[2], k2[3]); w.z = pk(k2[4], k2[5]); w.w = pk(k2[6], k2[7]); *(u32x4*)(Kr + j * QS + 32 + ds * 8) = w;
      const bf16_t* vp = proj + tok * 3072 + 1536 + h * 64 + ds * 16;
#pragma unroll
      for (int hv = 0; hv < 2; ++hv) { const u32x4 v = *(const u32x4*)(vp + hv * 8);
#pragma unroll
          for (int jj = 0; jj < 8; ++jj) Vt[(ds * 16 + hv * 8 + jj) * VS + j] = (unsigned short)((jj & 1) ? (v[jj >> 1] >> 16) : (v[jj >> 1] & 0xffffu)); } }
    __syncthreads();
    { const int it = wid, il = it * 16 + fr;
      const bf16x8 Qb0 = *(const bf16x8*)(Qr + il * QS + fq * 8), Qb1 = *(const bf16x8*)(Qr + il * QS + 32 + fq * 8);
      f32x4 ot[4];
#pragma unroll
      for (int et = 0; et < 4; ++et) ot[et] = (f32x4){0.f, 0.f, 0.f, 0.f};
#pragma unroll
      for (int jg = 0; jg < 4; ++jg) { float pv[8];
#pragma unroll
          for (int t = 0; t < 2; ++t) { const int jrow = jg * 32 + (fr >> 2) * 8 + 4 * t + (fr & 3);
              const bf16x8 A0 = *(const bf16x8*)(Kr + jrow * QS + fq * 8), A1 = *(const bf16x8*)(Kr + jrow * QS + 32 + fq * 8);
              f32x4 s = {0.f, 0.f, 0.f, 0.f}; s = mfma16(A0, Qb0, s); s = mfma16(A1, Qb1, s);
#pragma unroll
              for (int e = 0; e < 4; ++e) { const int jj = jg * 32 + fq * 8 + 4 * t + e; const int dist = il > jj ? il - jj : jj - il;
                  pv[t * 4 + e] = s[e] * exp2f((float)dist * l2g); } }
          u32x4 pw; pw.x = pk(pv[0], pv[1]); pw.y = pk(pv[2], pv[3]); pw.z = pk(pv[4], pv[5]); pw.w = pk(pv[6], pv[7]); const bf16x8 pf = as_frag(pw);
#pragma unroll
          for (int et = 0; et < 4; ++et) { const bf16x8 vf = *(const bf16x8*)(Vt + (et * 16 + fr) * VS + jg * 32 + fq * 8); ot[et] = mfma16(vf, pf, ot[et]); } }
      const bf16_t* stf = st + (size_t)item * 2 * 4096; const bf16_t* stb = stf + 4096;
      const float wfi = exp2f((float)(il + 1) * l2g), wbi = exp2f((float)(128 - il) * l2g);
      float sum = 0.f;
#pragma unroll
      for (int et = 0; et < 4; ++et) { f32x4 af = {0.f, 0.f, 0.f, 0.f}, ab = {0.f, 0.f, 0.f, 0.f};
          const bf16_t* pf0 = stf + (et * 16 + fr) * 64 + fq * 8; const bf16_t* pb0 = stb + (et * 16 + fr) * 64 + fq * 8;
          af = mfma16(*(const bf16x8*)pf0, Qb0, af); af = mfma16(*(const bf16x8*)(pf0 + 32), Qb1, af);
          ab = mfma16(*(const bf16x8*)pb0, Qb0, ab); ab = mfma16(*(const bf16x8*)(pb0 + 32), Qb1, ab);
          ot[et] = ot[et] + af * wfi + ab * wbi; sum += (ot[et][0] + ot[et][1]) + (ot[et][2] + ot[et][3]); }
      sum += __shfl_xor(sum, 16); sum += __shfl_xor(sum, 32);
      const float mu = sum * (1.0f / 64.0f); float q = 0.f;
#pragma unroll
      for (int et = 0; et < 4; ++et) { ot[et] = ot[et] - mu; q += (ot[et][0] * ot[et][0] + ot[et][1] * ot[et][1]) + (ot[et][2] * ot[et][2] + ot[et][3] * ot[et][3]); }
      q += __shfl_xor(q, 16); q += __shfl_xor(q, 32);
      const float rstd = rsqrtf(q * (1.0f / 64.0f) + 1e-6f);
      const size_t tok = (size_t)b * 4096 + n * 128 + il;
      const bf16_t* gp = proj + tok * 3072 + 1920 + h * 64 + fq * 4; bf16_t* yp = y + tok * 1024 + 384 + h * 64 + fq * 4; const float* gw = gnw + h * 64 + fq * 4;
#pragma unroll
      for (int et = 0; et < 4; ++et) { const u32x2 gv = *(const u32x2*)(gp + et * 16); const f32x4 w4 = *(const f32x4*)(gw + et * 16);
          const float g0 = bflo(gv.x), g1 = bfhi(gv.x), g2 = bflo(gv.y), g3 = bfhi(gv.y);
          const float o0 = ot[et][0] * rstd * w4[0] * (g0 * sigm(g0)), o1 = ot[et][1] * rstd * w4[1] * (g1 * sigm(g1));
          const float o2 = ot[et][2] * rstd * w4[2] * (g2 * sigm(g2)), o3 = ot[et][3] * rstd * w4[3] * (g3 * sigm(g3));
          u32x2 w; w.x = pk(o0, o1); w.y = pk(o2, o3); *(u32x2*)(yp + et * 16) = w; } }
    __syncthreads();
}

template <bool FINAL>
__device__ void lru_item(const Params& p, int l, int item, int lane) {
    const int g = item % 6, ch = (item / 6) & 63, b = item / 384, fr = lane & 15, fq = lane >> 4;
    const bf16_t* proj = (const bf16_t*)(p.ws + WS_R1);
    const float* cw = p.in[2] + l * 4 * 384; const float* cb = p.in[3] + l * 384;
    const int t0 = ch * 64;
    bf16x8 A[4][2];
#pragma unroll
    for (int ks = 0; ks < 2; ++ks) { const int c = g * 64 + ks * 32 + fq * 8; float w[4][8], bias[8];
#pragma unroll
        for (int tap = 0; tap < 4; ++tap) { const float4 w0 = *(const float4*)(cw + tap * 384 + c), w1 = *(const float4*)(cw + tap * 384 + c + 4);
            w[tap][0] = w0.x; w[tap][1] = w0.y; w[tap][2] = w0.z; w[tap][3] = w0.w; w[tap][4] = w1.x; w[tap][5] = w1.y; w[tap][6] = w1.z; w[tap][7] = w1.w; }
        { const float4 b0 = *(const float4*)(cb + c), b1 = *(const float4*)(cb + c + 4);
          bias[0] = b0.x; bias[1] = b0.y; bias[2] = b0.z; bias[3] = b0.w; bias[4] = b1.x; bias[5] = b1.y; bias[6] = b1.z; bias[7] = b1.w; }
#pragma unroll
        for (int tt = 0; tt < 4; ++tt) { const int t = t0 + tt * 16 + fr; float acc[8];
#pragma unroll
            for (int jj = 0; jj < 8; ++jj) acc[jj] = bias[jj];
#pragma unroll
            for (int tap = 0; tap < 4; ++tap) { const int tp = t + tap - 2; u32x4 v = {0u, 0u, 0u, 0u};
                if (tp >= 0 && tp < SEQ) v = *(const u32x4*)(proj + ((size_t)b * 4096 + tp) * 3072 + c);
#pragma unroll
                for (int jj = 0; jj < 8; ++jj) acc[jj] += BFEL(v, jj) * w[tap][jj]; }
            u32x4 pw; pw.x = pk(acc[0], acc[1]); pw.y = pk(acc[2], acc[3]); pw.z = pk(acc[4], acc[5]); pw.w = pk(acc[6], acc[7]); A[tt][ks] = as_frag(pw); asm volatile("" ::: "memory"); } }
    const bf16_t* lw = (const bf16_t*)(p.ws + WS_LRUW);
#pragma unroll 1
    for (int ot = 0; ot < 4; ++ot) {
        const int o = ot * 16 + fr, cgi = g * 64 + o;
        f32x4 xcC[4];
        { u32x4 i0, i1;
#pragma unroll
          for (int dw = 0; dw < 4; ++dw) { const int m0 = o - fq * 8, m1 = o - 32 - fq * 8;
              i0[dw] = (m0 == 2 * dw ? 0x3F80u : 0u) | (m0 == 2 * dw + 1 ? 0x3F800000u : 0u);
              i1[dw] = (m1 == 2 * dw ? 0x3F80u : 0u) | (m1 == 2 * dw + 1 ? 0x3F800000u : 0u); }
          const bf16x8 I0 = as_frag(i0), I1 = as_frag(i1);
#pragma unroll
          for (int tt = 0; tt < 4; ++tt) { f32x4 a = {0.f, 0.f, 0.f, 0.f}; a = mfma16(A[tt][0], I0, a); a = mfma16(A[tt][1], I1, a); xcC[tt] = a; } }
        float hs[4][4];
#pragma unroll
        for (int tt = 0; tt < 4; ++tt)
#pragma unroll
            for (int e = 0; e < 4; ++e) hs[tt][e] = 0.f;
#pragma unroll
        for (int dir = 0; dir < 2; ++dir) {
            const bf16_t* wa = lw + (size_t)((((l * 2 + dir) * 2 + 0) * 6 + g)) * 4096 + o * 64 + fq * 8; const bf16_t* wx = wa + 6 * 4096;
            const bf16x8 Ba0 = *(const bf16x8*)wa, Ba1 = *(const bf16x8*)(wa + 32), Bx0 = *(const bf16x8*)wx, Bx1 = *(const bf16x8*)(wx + 32);
            const int pi = (l * 2 + dir) * 384 + cgi;
            const float ba = p.in[5][pi], bx = p.in[7][pi], lam = p.in[8][pi];
            const float nl = -lam; const float sp = fmaxf(nl, 0.f) + log1pf(expf(-fabsf(nl)));
            const float m8sp = -8.0f * sp;
            const size_t aidx = ((size_t)(b * 64 + ch) * 2 + dir) * 384 + cgi;
            float Hc = 0.f, Acc = 1.f;
            if (FINAL) Hc = ((const float*)(p.ws + WS_CARRY))[aidx];
#pragma unroll
            for (int step = 0; step < 4; ++step) { const int tt = dir ? 3 - step : step;
                f32x4 pa = {0.f, 0.f, 0.f, 0.f}, px = {0.f, 0.f, 0.f, 0.f};
                pa = mfma16(A[tt][0], Ba0, pa); pa = mfma16(A[tt][1], Ba1, pa); px = mfma16(A[tt][0], Bx0, px); px = mfma16(A[tt][1], Bx1, px);
                float av[4], uv[4];
#pragma unroll
                for (int e = 0; e < 4; ++e) { const float r = sigm(pa[e] + ba), ii = sigm(px[e] + bx); const float la = m8sp * r; const float a = __expf(la); const float y2 = 2.0f * la;
                    const float em = (y2 > -0.05f) ? -y2 * (1.0f + y2 * (0.5f + y2 * (0.16666667f + y2 * 0.041666668f))) : 1.0f - __expf(y2);
                    av[e] = a; uv[e] = sqrtf(em) * ii * xcC[tt][e]; }
                float Aq, Uq;
                if (dir == 0) { Aq = av[0]; Uq = uv[0];
#pragma unroll
                    for (int e = 1; e < 4; ++e) { Uq = av[e] * Uq + uv[e]; Aq *= av[e]; } }
                else { Aq = av[3]; Uq = uv[3];
#pragma unroll
                    for (int e = 2; e >= 0; --e) { Uq = av[e] * Uq + uv[e]; Aq *= av[e]; } }
                float Aall[4], Uall[4];
#pragma unroll
                for (int q = 0; q < 4; ++q) { Aall[q] = __shfl(Aq, q * 16 + fr); Uall[q] = __shfl(Uq, q * 16 + fr); }
                float hq = Hc, hh = Hc;
#pragma unroll
                for (int qq = 0; qq < 4; ++qq) { const int q = dir ? 3 - qq : qq; const bool before = dir ? (q > fq) : (q < fq);
                    if (before) hq = Aall[q] * hq + Uall[q];
                    hh = Aall[q] * hh + Uall[q]; Acc *= Aall[q]; }
                Hc = hh;
                if (FINAL) {
                    if (dir == 0) {
#pragma unroll
                        for (int e = 0; e < 4; ++e) { hq = av[e] * hq + uv[e]; hs[tt][e] += hq; } }
                    else {
#pragma unroll
                        for (int e = 3; e >= 0; --e) { hq = av[e] * hq + uv[e]; hs[tt][e] += hq; } }
                }
            }
            if (!FINAL) { if (fq == 0) ((float2*)(p.ws + WS_AGG))[aidx] = make_float2(Acc, Hc); }
        }
        if (FINAL) { bf16_t* y = (bf16_t*)(p.ws + WS_Y); int tokb = b * 4096 + t0 + fq * 4; asm volatile("" : "+v"(tokb));
#pragma unroll
            for (int tt = 0; tt < 4; ++tt)
#pragma unroll
                for (int e = 0; e < 4; ++e) { const unsigned tok = (unsigned)(tokb + tt * 16 + e);
                    const float gt = __uint_as_float(((unsigned)proj[tok * 3072u + 384u + (unsigned)cgi]) << 16);
                    const float z = 0.7978845608028654f * (gt + 0.044715f * gt * gt * gt); const float th = 1.0f - 2.0f / (1.0f + __expf(2.0f * z));
                    y[tok * 1024u + (unsigned)cgi] = f2bf(hs[tt][e] * 0.5f * gt * (1.0f + th)); } }
    }
}

__device__ void phase_mix_a(const Params& p, int l, unsigned char* ldsg) {
    const int tid = tidx(), nb = gridDim.x, bid = bidx();
    const bf16_t* proj = (const bf16_t*)(p.ws + WS_R1);
    { float* rp = (float*)(ldsg + 75776); const float* src = p.in[10] + l * 1860; for (int i = tid; i < 1860; i += 512) rp[i] = src[i]; }
    __syncthreads();
    for (int t = bid; t < 2944; t += nb) {
        if (t < 1024) natten_item(proj, (bf16_t*)(p.ws + WS_Y), t, ldsg);
        else if (t < 2560) ret_a_item(proj, (const float2*)(p.ws + WS_ROPE), (float*)(p.ws + WS_KV), t - 1024, ldsg);
        else lru_item<false>(p, l, (t - 2560) * 8 + (tid >> 6), tid & 63);
    }
}
__device__ void phase_mix_b(const Params& p) {
    const int tid = tidx(), nb = gridDim.x, bid = bidx();
    for (int t = bid; t < 780; t += nb) {
        if (t < 768) { const int dir = t & 1, blk = (t >> 1) & 7, bh = t >> 4; const int h = bh % 6; const int el = blk * 512 + tid;
            const float gch = exp2f(128.0f * log2gamma(h));
            const float* kv = (const float*)(p.ws + WS_KV) + ((size_t)bh * 32 * 2 + dir) * 4096 + el; bf16_t* st = (bf16_t*)(p.ws + WS_ST) + ((size_t)bh * 32 * 2 + dir) * 4096 + el;
            float s = 0.f;
            if (dir == 0) { for (int n = 0; n < 32; ++n) { st[(size_t)n * 8192] = f2bf(s); s = gch * s + kv[(size_t)n * 8192]; } }
            else { for (int n = 31; n >= 0; --n) { st[(size_t)n * 8192] = f2bf(s); s = gch * s + kv[(size_t)n * 8192]; } }
        } else { const int idx = (t - 768) * 512 + tid;
            const int c = idx % 384, dir = (idx / 384) & 1, b = idx / 768;
            const float2* agg = (const float2*)(p.ws + WS_AGG); float* carry = (float*)(p.ws + WS_CARRY); float hcur = 0.f;
            if (dir == 0) { for (int ch = 0; ch < 64; ++ch) { const size_t ix = ((size_t)(b * 64 + ch) * 2 + dir) * 384 + c; carry[ix] = hcur; const float2 au = agg[ix]; hcur = au.x * hcur + au.y; } }
            else { for (int ch = 63; ch >= 0; --ch) { const size_t ix = ((size_t)(b * 64 + ch) * 2 + dir) * 384 + c; carry[ix] = hcur; const float2 au = agg[ix]; hcur = au.x * hcur + au.y; } }
        }
    }
}
__device__ void phase_mix_c(const Params& p, int l, unsigned char* ldsg) {
    const int tid = tidx(), nb = gridDim.x, bid = bidx();
    const bf16_t* proj = (const bf16_t*)(p.ws + WS_R1);
    for (int t = bid; t < 1536 + 384; t += nb) {
        if (t < 1536) { if (PHM & 16) ret_c_item(proj, (const float2*)(p.ws + WS_ROPE), (const bf16_t*)(p.ws + WS_ST), p.in[9] + l * 384, (bf16_t*)(p.ws + WS_Y), t, ldsg); }
        else if (PHM & 64) lru_item<true>(p, l, (t - 1536) * 8 + (tid >> 6), tid & 63);
    }
}

__device__ void run_phase(const Params& p, int ph, unsigned char* ldsg, LAS unsigned char* lds) {
    unsigned char* ws = p.ws;
    if (ph == 0) { if (PHM & 1) phase_init(p, ldsg); return; }
    const int l = (ph - 1) / 9, s = (ph - 1) % 9;
    pg8::StaticOrder S;
    if (s == 0 && (PHM & 2)) { pg8::Gemm g{(const bf16_t*)(ws + WS_XB), (const bf16_t*)(ws + WS_WIN) + (size_t)l * 3072 * 1024, MTOK, 3072, 1024};
        S.init(MTOK, 3072, gridDim.x, bidx()); EpiProj E{(bf16_t*)(ws + WS_R1)}; pg8::gemm_phase<EpiProj, pg8::StaticOrder>(lds, g, S, E, nullptr); }
    else if (s == 1 && (PHM & 4)) phase_mix_a(p, l, ldsg);
    else if (s == 2 && (PHM & 8)) phase_mix_b(p);
    else if (s == 3 && (PHM & 80)) phase_mix_c(p, l, ldsg);
    else if (s == 4 && (PHM & 128)) { pg8::Gemm g{(const bf16_t*)(ws + WS_Y), (const bf16_t*)(ws + WS_WOUT) + (size_t)l * 1024 * 1024, MTOK, 1024, 1024};
        S.init(MTOK, 1024, gridDim.x, bidx()); EpiResid E{l == 0 ? p.in[0] : p.out, (float*)(ws + WS_R1)}; pg8::gemm_phase<EpiResid, pg8::StaticOrder>(lds, g, S, E, nullptr); }
    else if (s == 5 && (PHM & 32)) phase_ln((const float*)(ws + WS_R1), p.in[12] + l * 1024, p.in[13] + l * 1024, p.out, (bf16_t*)(ws + WS_XB));
    else if (s == 6 && (PHM & 256)) { pg8::Gemm g{(const bf16_t*)(ws + WS_XB), (const bf16_t*)(ws + WS_WGU) + (size_t)l * 5632 * 1024, MTOK, 5632, 1024};
        S.init(MTOK, 5632, gridDim.x, bidx()); EpiSwiglu E{(bf16_t*)(ws + WS_R1)}; pg8::gemm_phase<EpiSwiglu, pg8::StaticOrder>(lds, g, S, E, nullptr); }
    else if (s == 7 && (PHM & 128)) { pg8::Gemm g{(const bf16_t*)(ws + WS_R1), (const bf16_t*)(ws + WS_WD) + (size_t)l * 1024 * 2816, MTOK, 1024, 2816};
        S.init(MTOK, 1024, gridDim.x, bidx()); EpiResid E{p.out, (float*)(ws + WS_R2)}; pg8::gemm_phase<EpiResid, pg8::StaticOrder>(lds, g, S, E, nullptr); }
    else if (s == 8 && (PHM & 32)) phase_ln((const float*)(ws + WS_R2), p.in[17] + l * 1024, p.in[18] + l * 1024, p.out, (bf16_t*)(ws + WS_XB));
}

__global__ void __launch_bounds__(512) fwd_mega(Params p) {
    extern __shared__ __attribute__((aligned(16))) unsigned char ldsg[];
    LAS unsigned char* lds = (LAS unsigned char*)ldsg;
    cg::grid_group grid = cg::this_grid();
    for (int ph = p.ph_lo; ph < p.ph_hi; ++ph) {
        run_phase(p, ph, ldsg, lds);
        if (p.coop && ph + 1 < p.ph_hi) grid.sync();
    }
}

#ifndef N_LAUNCH_MODE
#define N_LAUNCH_MODE 0
#endif
extern "C" void kernel_launch(void* const* d_in, const int* in_sizes, int n_in, void* d_out, int out_size, void* d_ws, size_t ws_size, hipStream_t stream) {
    static int grid = 0;
    if (grid == 0) {
        int dev = 0, cus = 0, per_cu = 0;
        hipGetDevice(&dev); hipDeviceGetAttribute(&cus, hipDeviceAttributeMultiprocessorCount, dev);
        hipFuncSetAttribute((const void*)fwd_mega, hipFuncAttributeMaxDynamicSharedMemorySize, LDS_BYTES);
        hipOccupancyMaxActiveBlocksPerMultiprocessor(&per_cu, (const void*)fwd_mega, 512, LDS_BYTES);
        (void)hipGetLastError();
        if (per_cu < 1) per_cu = 1;
        grid = cus * 1;
        if (ws_size < WS_END) fprintf(stderr, "kernel_launch: workspace too small: %zu < %zu\n", ws_size, (size_t)WS_END);
    }
    Params p{};
    for (int i = 0; i < 19; ++i) p.in[i] = (const float*)d_in[i];
    p.out = (float*)d_out; p.ws = (unsigned char*)d_ws;
#if N_LAUNCH_MODE == 1
    p.ph_lo = 0; p.ph_hi = NPHASE; p.coop = 1;
    void* args[] = {&p};
    hipError_t e = hipLaunchCooperativeKernel((const void*)fwd_mega, dim3(grid), dim3(512), args, LDS_BYTES, stream);
    if (e != hipSuccess) fprintf(stderr, "cooperative launch failed: %s (grid %d)\n", hipGetErrorString(e), grid);
#else
    for (int ph = 0; ph < NPHASE; ++ph) { p.ph_lo = ph; p.ph_hi = ph + 1; p.coop = 0;
        hipLaunchKernelGGL(fwd_mega, dim3(grid), dim3(512), LDS_BYTES, stream, p); }
#endif
}
```

```cpp
#include <hip/hip_runtime.h>
#include <hip/hip_cooperative_groups.h>
#include <cstdio>
namespace cg = cooperative_groups;
namespace pg8 {
#define PG8_LAS __attribute__((address_space(3)))
typedef unsigned short bf16_t;
typedef short bf16x8 __attribute__((ext_vector_type(8)));
typedef float f32x4 __attribute__((ext_vector_type(4)));
typedef unsigned u32x4 __attribute__((ext_vector_type(4)));
constexpr int BM = 256, BK = 64, HALF = 128, HTB = HALF * BK * 2  , STAGE_BYTES = 8 * HTB, NXCD = 8, WGM = 8;

__host__ __device__ __forceinline__ int lds_byte(int r, int c) { const int st = (r >> 4) * 2 + (c >> 5), rr = r & 15, cc = c & 31, ob = rr * 64 + cc * 2; return st * 1024 + (ob ^ (((ob >> 9) & 1) << 5)); }
__host__ __device__ __forceinline__ void stage_rc(int b, int& R, int& C) { const int st = b / 1024, sb = b % 1024, swz = sb ^ (((sb >> 9) & 1) << 5); R = (st >> 1) * 16 + swz / 64; C = (st & 1) * 32 + (swz % 64) / 2; }
__host__ __device__ __forceinline__ int perm32(int rho) { const int n = rho >> 4, i = rho & 15; return 8 * (i >> 2) + 4 * n + (i & 3); }

struct Unit { int pm, pn; };
struct Gemm { const bf16_t* A; const bf16_t* Bt; int M, N, K; };

struct StaticOrder {
    int nM, nN, nwg, G, c;
    __host__ __device__ void init(int M, int N, int G_, int c_) { nM = M / BM; nN = N / BM; nwg = nM * nN; G = G_; c = c_; }
    __host__ __device__ bool next(int i, Unit& u) const {
        const long L = (long)i * G + c; if (L >= nwg) return false;
        int wgid = (int)L; { const int q = nwg / NXCD, r = nwg % NXCD, xcd = wgid % NXCD, off = wgid / NXCD; wgid = (xcd < r ? xcd * (q + 1) : r * (q + 1) + (xcd - r) * q) + off; }
        const int nig = WGM * nN, gid = wgid / nig, fm = gid * WGM, gsz = (nM - fm) < WGM ? (nM - fm) : WGM;
        u.pm = fm + ((wgid % nig) % gsz); u.pn = (wgid % nig) / gsz; return true;
    }
    __device__ __forceinline__ void a_ready(const Unit&) const {}
    __device__ __forceinline__ void done(const Unit&) const {}
};
typedef float cvt_f32x2 __attribute__((ext_vector_type(2)));
typedef __bf16 cvt_bf16x2 __attribute__((ext_vector_type(2)));
__device__ __forceinline__ unsigned cvt_pk_bf16(float lo, float hi) { const cvt_f32x2 v = {lo, hi}; const cvt_bf16x2 b = __builtin_convertvector(v, cvt_bf16x2); return __builtin_bit_cast(unsigned, b); }
template <class Epi, class Sched, bool STAMP = false>
__device__ __forceinline__ void gemm_phase(PG8_LAS unsigned char* lds, const Gemm g, const Sched& S, const Epi& E, unsigned long long* stamps) {
    int tid = threadIdx.x; asm volatile("" : "+v"(tid)); const int wid = __builtin_amdgcn_readfirstlane(tid >> 6), lane = tid & 63, wr = wid >> 2, wc = wid & 3, fr = lane & 15, fq = lane >> 4;
    const int K = g.K, nt = K / BK;
    int ts_lo = 0, ts_hi = 0, nts = 0; const unsigned long long rt_entry = STAMP ? (unsigned long long)wall_clock64() : 0ull;
#define PG8_STAMP() do { if (STAMP && wid == 0 && nts < 64) { const unsigned long long _c = (unsigned long long)clock64(); \
        ts_lo = (lane == nts) ? (int)(unsigned)_c : ts_lo; ts_hi = (lane == nts) ? (int)(unsigned)(_c >> 32) : ts_hi; ++nts; } } while (0)
    PG8_STAMP();
    unsigned voffA[2], voffB[2];
#pragma unroll
    for (int i = 0; i < 2; ++i) { int R, C; stage_rc(tid * 16 + i * 8192, R, C); const int Rb = Epi::PERM ? ((R & ~31) + perm32(R & 31)) : R;
        voffA[i] = (unsigned)(R * K + C) * 2u; voffB[i] = (unsigned)(Rb * K + C) * 2u; }
    const size_t kstep = (size_t)(BK * 2);
    const size_t hstep = (size_t)HALF * K * 2;
    const size_t tstep = 2 * hstep;
    const unsigned ldsw = (unsigned)wid * 1024u;
    const int aoff = lds_byte(wr * 64 + fr, fq * 8), boff = lds_byte(wc * 32 + fr, fq * 8);
#define PG8_SA(b, h) (((b) * 2 + (h)) * HTB)
#define PG8_SB(b, h) ((4 + (b) * 2 + (h)) * HTB)
#define PG8_STAGE(bufoff, gbase, voff) do { _Pragma("unroll") for (int _i = 0; _i < 2; ++_i) \
        __builtin_amdgcn_global_load_lds((const unsigned*)((const char*)(gbase) + (voff)[_i]), (PG8_LAS unsigned*)(lds + (bufoff) + ldsw + _i * 8192), 16, 0, 0); } while (0)
#define PG8_LDA(dst, b, h) do { _Pragma("unroll") for (int m = 0; m < 4; ++m) _Pragma("unroll") for (int k = 0; k < 2; ++k) dst[m][k] = *(const PG8_LAS bf16x8*)(lds + PG8_SA(b, h) + aoff + m * 2048 + k * 1024); } while (0)
#define PG8_LDB(dst, b, h) do { _Pragma("unroll") for (int n = 0; n < 2; ++n) _Pragma("unroll") for (int k = 0; k < 2; ++k) dst[n][k] = *(const PG8_LAS bf16x8*)(lds + PG8_SB(b, h) + boff + n * 2048 + k * 1024); } while (0)
#define PG8_MMA(ai, bj, At, Bt) do { __builtin_amdgcn_s_setprio(1); _Pragma("unroll") for (int m = 0; m < 4; ++m) _Pragma("unroll") for (int n = 0; n < 2; ++n) _Pragma("unroll") for (int k = 0; k < 2; ++k) \
        acc[ai][bj][m][n] = __builtin_amdgcn_mfma_f32_16x16x32_bf16(Bt[n][k], At[m][k], acc[ai][bj][m][n], 0, 0, 0); __builtin_amdgcn_s_setprio(0); } while (0)
#define PG8_WAIT_V(n) asm volatile("s_waitcnt vmcnt(" #n ")" ::: "memory")
#define PG8_WAIT_L(n) asm volatile("s_waitcnt lgkmcnt(" #n ")" ::: "memory")
#define PG8_BAR __builtin_amdgcn_s_barrier()
#define PG8_SCHED __builtin_amdgcn_sched_barrier(0)
    Unit cur, nxt; int ui = 0;
    if (!S.next(0, cur)) return;
    f32x4 acc[2][2][4][2];
#pragma unroll
    for (int a = 0; a < 2; ++a)
#pragma unroll
        for (int b = 0; b < 2; ++b)
#pragma unroll
            for (int m = 0; m < 4; ++m)
#pragma unroll
                for (int n = 0; n < 2; ++n) acc[a][b][m][n] = (f32x4){0.f, 0.f, 0.f, 0.f};
    bf16x8 At[4][2], B0[2][2], B1[2][2];
    const char* cA = (const char*)g.A + (size_t)cur.pm * tstep; const char* cB = (const char*)g.Bt + (size_t)cur.pn * tstep;
    S.a_ready(cur);
    PG8_STAGE(PG8_SB(0, 0), cB, voffB); PG8_STAGE(PG8_SA(0, 0), cA, voffA); PG8_STAGE(PG8_SB(0, 1), cB + hstep, voffB); PG8_STAGE(PG8_SA(0, 1), cA + hstep, voffA);
    if (wr == 1) PG8_BAR;
    PG8_WAIT_V(4); PG8_BAR;
    PG8_STAGE(PG8_SB(1, 0), cB + kstep, voffB); PG8_STAGE(PG8_SA(1, 0), cA + kstep, voffA); PG8_STAGE(PG8_SB(1, 1), cB + hstep + kstep, voffB);
    PG8_WAIT_V(6); PG8_BAR;
    PG8_STAMP();
    for (;;) {
        const bool has_next = S.next(ui + 1, nxt);
        const char* nA = has_next ? (const char*)g.A + (size_t)nxt.pm * tstep : cA; const char* nB = has_next ? (const char*)g.Bt + (size_t)nxt.pn * tstep : cB;
        for (int t = 0; t < nt; t += 2) {
            const bool last = (t == nt - 2);
            const char* a1 = cA + (size_t)(t + 1) * kstep;
            const char* a2 = last ? nA : cA + (size_t)(t + 2) * kstep; const char* b2 = last ? nB : cB + (size_t)(t + 2) * kstep;
            const char* a3 = a2 + kstep; const char* b3 = b2 + kstep;
            if (last && has_next) S.a_ready(nxt);
            PG8_LDB(B0, 0, 0); PG8_SCHED; PG8_LDA(At, 0, 0); PG8_STAGE(PG8_SA(1, 1), a1 + hstep, voffA);
            PG8_WAIT_L(8); PG8_BAR; PG8_WAIT_L(0); PG8_MMA(0, 0, At, B0); PG8_BAR; PG8_SCHED;
            PG8_LDB(B1, 0, 1); PG8_STAGE(PG8_SB(0, 0), b2, voffB);
            PG8_BAR; PG8_WAIT_L(0); PG8_MMA(0, 1, At, B1); PG8_BAR;
            PG8_LDA(At, 0, 1); PG8_STAGE(PG8_SA(0, 0), a2, voffA);
            PG8_BAR; PG8_WAIT_L(0); PG8_MMA(1, 0, At, B0); PG8_BAR; PG8_SCHED;
            PG8_STAGE(PG8_SB(0, 1), b2 + hstep, voffB);
            PG8_WAIT_V(6); PG8_BAR; PG8_MMA(1, 1, At, B1); PG8_BAR;
            PG8_LDB(B0, 1, 0); PG8_SCHED; PG8_LDA(At, 1, 0); PG8_STAGE(PG8_SA(0, 1), a2 + hstep, voffA);
            PG8_WAIT_L(8); PG8_BAR; PG8_WAIT_L(0); PG8_MMA(0, 0, At, B0); PG8_BAR; PG8_SCHED;
            PG8_LDB(B1, 1, 1); PG8_STAGE(PG8_SB(1, 0), b3, voffB);
            PG8_BAR; PG8_WAIT_L(0); PG8_MMA(0, 1, At, B1); PG8_BAR;
            PG8_LDA(At, 1, 1); PG8_STAGE(PG8_SA(1, 0), a3, voffA);
            PG8_BAR; PG8_WAIT_L(0); PG8_MMA(1, 0, At, B0); PG8_BAR; PG8_SCHED;
            PG8_STAGE(PG8_SB(1, 1), b3 + hstep, voffB);
            PG8_WAIT_V(6); PG8_BAR; PG8_MMA(1, 1, At, B1); PG8_BAR;
        }
        PG8_STAMP();
        if constexpr (!Epi::AFTER_DRAIN) { E(acc, cur, wr, wc, fr, fq); S.done(cur); }
        PG8_STAMP();
        if (!has_next) break;
#pragma unroll
        for (int a = 0; a < 2; ++a)
#pragma unroll
            for (int b = 0; b < 2; ++b)
#pragma unroll
                for (int m = 0; m < 4; ++m)
#pragma unroll
                    for (int n = 0; n < 2; ++n) acc[a][b][m][n] = (f32x4){0.f, 0.f, 0.f, 0.f};
        cur = nxt; cA = nA; cB = nB; ++ui;
    }
    PG8_WAIT_V(0);
    if (wr == 0) PG8_BAR;
    PG8_BAR;
    if constexpr (Epi::AFTER_DRAIN) { E.fused(acc, cur, wr, wc, fr, fq, lds, wid, lane); S.done(cur); }
    PG8_STAMP();
    if (STAMP && wid == 0) { stamps[lane] = lane < nts ? (((unsigned long long)(unsigned)ts_hi << 32) | (unsigned)ts_lo) : 0ull;
        if (lane == 62) stamps[62] = rt_entry; if (lane == 63) stamps[63] = (unsigned long long)wall_clock64(); }
#undef PG8_STAMP
#undef PG8_SA
#undef PG8_SB
#undef PG8_STAGE
#undef PG8_LDA
#undef PG8_LDB
#undef PG8_MMA
#undef PG8_WAIT_V
#undef PG8_WAIT_L
#undef PG8_BAR
#undef PG8_SCHED
}
}

using pg8::bf16_t; using pg8::bf16x8; using pg8::f32x4; using pg8::u32x4;
typedef unsigned u32x2 __attribute__((ext_vector_type(2)));
#define LAS __attribute__((address_space(3)))

constexpr int SEQ = 4096, MTOK = 32768, NL = 4;
constexpr float ALPHA = 1.681792830507429f;
constexpr int LDS_BYTES = 131072 + 16;
constexpr int NPHASE = 1 + 9 * NL;
constexpr int XCD_BAR_BYTES = 3456 * 4;

constexpr size_t WS_WIN = 0;
constexpr size_t WS_WOUT = WS_WIN + (size_t)NL * 3072 * 1024 * 2;
constexpr size_t WS_WGU = WS_WOUT + (size_t)NL * 1024 * 1024 * 2;
constexpr size_t WS_WD = WS_WGU + (size_t)NL * 5632 * 1024 * 2;
constexpr size_t WS_LRUW = WS_WD + (size_t)NL * 1024 * 2816 * 2;
constexpr size_t WS_ROPE = WS_LRUW + (size_t)NL * 2 * 2 * 6 * 4096 * 2;
constexpr size_t WS_XB = WS_ROPE + (size_t)4096 * 32 * 8;
constexpr size_t WS_R1 = WS_XB + (size_t)MTOK * 1024 * 2;
constexpr size_t WS_R2 = WS_R1 + (size_t)MTOK * 3072 * 2;
constexpr size_t WS_Y = WS_R2;
constexpr size_t WS_KV = WS_Y + (size_t)MTOK * 1024 * 2;
constexpr size_t WS_ST = WS_KV + (size_t)1536 * 2 * 4096 * 4;
constexpr size_t WS_R2END = WS_ST + (size_t)1536 * 2 * 4096 * 2;
constexpr size_t WS_AGG = WS_R2END;
constexpr size_t WS_CARRY = WS_AGG + (size_t)8 * 128 * 2 * 384 * 8;
constexpr size_t WS_BAR = WS_CARRY + (size_t)8 * 128 * 2 * 384 * 4;
constexpr size_t WS_LRUC = WS_BAR + (size_t)XCD_BAR_BYTES + 4096;
constexpr size_t WS_END = WS_LRUC + (size_t)NL * 2 * 384 * 16;

__device__ __forceinline__ int tidx() { int t = threadIdx.x; asm volatile("" : "+v"(t)); return t; }
__device__ __forceinline__ int bidx() { int b = blockIdx.x; asm volatile("" : "+s"(b)); return b; }
struct Params { const float* in[19]; float* out; unsigned char* ws; int ph_lo, ph_hi, coop, pad; };

__device__ __forceinline__ float bflo(unsigned w) { return __uint_as_float(w << 16); }
__device__ __forceinline__ float bfhi(unsigned w) { return __uint_as_float(w & 0xffff0000u); }
#define BFEL(v, jj) (((jj) & 1) ? bfhi((v)[(jj) >> 1]) : bflo((v)[(jj) >> 1]))
__device__ __forceinline__ unsigned pk(float lo, float hi) { return pg8::cvt_pk_bf16(lo, hi); }
__device__ __forceinline__ unsigned short f2bf(float f) { return (unsigned short)(pk(f, 0.f) & 0xffffu); }
__device__ __forceinline__ bf16x8 as_frag(u32x4 v) { return __builtin_bit_cast(bf16x8, v); }
__device__ __forceinline__ f32x4 mfma16(bf16x8 a, bf16x8 b, f32x4 c) { return __builtin_amdgcn_mfma_f32_16x16x32_bf16(a, b, c, 0, 0, 0); }
__device__ __forceinline__ float sigm(float x) { return __builtin_amdgcn_rcpf(1.0f + __builtin_amdgcn_exp2f(x * -1.4426950408889634f)); }
__device__ __forceinline__ float log2gamma(int h) {
    return h == 0 ? -0.04580368961312479f : h == 1 ? -0.02272007650008353f : h == 2 ? -0.011315313227834146f
         : h == 3 ? -0.005646563141142063f : h == 4 ? -0.0028205190623786626f : -0.0014095702546713536f;
}
__device__ __forceinline__ int clampi(int v, int lo, int hi) { return v < lo ? lo : (v > hi ? hi : v); }

struct EpiProj {
    static constexpr bool PERM = true, AFTER_DRAIN = false;
    bf16_t* O; int ldc;
    __device__ __forceinline__ void operator()(const f32x4 (&acc)[2][2][4][2], const pg8::Unit& u, int wr, int wc, int fr, int fq) const {
        const int row0 = u.pm * 256 + wr * 64 + fr, col0 = u.pn * 256 + wc * 32 + 8 * fq;
#pragma unroll
        for (int ai = 0; ai < 2; ++ai)
#pragma unroll
            for (int m = 0; m < 4; ++m) { bf16_t* rowp = O + (size_t)(row0 + ai * 128 + m * 16) * ldc + col0;
#pragma unroll
                for (int bj = 0; bj < 2; ++bj) { const f32x4 v0 = acc[ai][bj][m][0], v1 = acc[ai][bj][m][1];
                    u32x4 w; w.x = pk(v0[0], v0[1]); w.y = pk(v0[2], v0[3]); w.z = pk(v1[0], v1[1]); w.w = pk(v1[2], v1[3]);
                    *(u32x4*)(rowp + bj * 128) = w; } asm volatile("" ::: "memory"); }
    }
};
struct EpiSwiglu {
    static constexpr bool PERM = false, AFTER_DRAIN = false;
    bf16_t* H;
    __device__ __forceinline__ void operator()(const f32x4 (&acc)[2][2][4][2], const pg8::Unit& u, int wr, int wc, int fr, int fq) const {
        const int row0 = u.pm * 256 + wr * 64 + fr, h0 = u.pn * 128 + wc * 32 + 8 * fq;
#pragma unroll
        for (int ai = 0; ai < 2; ++ai)
#pragma unroll
            for (int m = 0; m < 4; ++m) { bf16_t* rowp = H + (size_t)(row0 + ai * 128 + m * 16) * 2816 + h0; float hv[8];
#pragma unroll
                for (int bj = 0; bj < 2; ++bj) { const f32x4 g = acc[ai][bj][m][0], uu = acc[ai][bj][m][1];
#pragma unroll
                    for (int e = 0; e < 4; ++e) hv[bj * 4 + e] = g[e] * sigm(g[e]) * uu[e]; }
                u32x4 w; w.x = pk(hv[0], hv[1]); w.y = pk(hv[2], hv[3]); w.z = pk(hv[4], hv[5]); w.w = pk(hv[6], hv[7]);
                *(u32x4*)rowp = w; asm volatile("" ::: "memory"); }
    }
};

__device__ void phase_init(const Params& p, unsigned char* ldsg) {
    const int tid = tidx(), nb = gridDim.x, bid = bidx();
    float* tile = (float*)ldsg;
    unsigned char* ws = p.ws;
    for (int T = bid; T < NL * 3136; T += nb) {
        const int l = T / 3136; int r = T % 3136;
        const float* src; int ldsrc, lddst, k0, n0, mode = 0; bf16_t* dst;
        if (r >= 2368) { r -= 2368; src = p.in[1] + (size_t)l * 1024 * 3072; ldsrc = 3072; dst = (bf16_t*)(ws + WS_WIN) + (size_t)l * 3072 * 1024; lddst = 1024; k0 = (r / 48) * 64; n0 = (r % 48) * 64; }
        else if (r < 256) { src = p.in[11] + (size_t)l * 1024 * 1024; ldsrc = 1024; dst = (bf16_t*)(ws + WS_WOUT) + (size_t)l * 1024 * 1024; lddst = 1024; k0 = (r / 16) * 64; n0 = (r % 16) * 64; }
        else if (r < 960) { r -= 256; src = p.in[14] + (size_t)l * 1024 * 2816; ldsrc = 2816; dst = (bf16_t*)(ws + WS_WGU) + (size_t)l * 5632 * 1024; lddst = 1024; k0 = (r / 44) * 64; n0 = (r % 44) * 64; mode = 1; }
        else if (r < 1664) { r -= 960; src = p.in[15] + (size_t)l * 1024 * 2816; ldsrc = 2816; dst = (bf16_t*)(ws + WS_WGU) + (size_t)l * 5632 * 1024; lddst = 1024; k0 = (r / 44) * 64; n0 = (r % 44) * 64; mode = 2; }
        else { r -= 1664; src = p.in[16] + (size_t)l * 2816 * 1024; ldsrc = 1024; dst = (bf16_t*)(ws + WS_WD) + (size_t)l * 1024 * 2816; lddst = 2816; k0 = (r / 16) * 64; n0 = (r % 16) * 64; }
#pragma unroll
        for (int i = 0; i < 2; ++i) { const int k = (tid >> 4) + 32 * i, n4 = (tid & 15) * 4;
            const float4 v = *(const float4*)(src + (size_t)(k0 + k) * ldsrc + n0 + n4);
            tile[k * 65 + n4 + 0] = v.x; tile[k * 65 + n4 + 1] = v.y; tile[k * 65 + n4 + 2] = v.z; tile[k * 65 + n4 + 3] = v.w; }
        __syncthreads();
        { const int n = tid >> 3, k8 = (tid & 7) * 8; float f[8];
#pragma unroll
            for (int j = 0; j < 8; ++j) f[j] = tile[(k8 + j) * 65 + n];
            const int ng = n0 + n; int drow = ng;
            if (mode) { const int hh = ng & 127; drow = (ng >> 7) * 256 + 128 * ((hh >> 2) & 1) + 32 * (hh >> 5) + 16 * (mode - 1) + 4 * ((hh >> 3) & 3) + (hh & 3); }
            u32x4 w; w.x = pk(f[0], f[1]); w.y = pk(f[2], f[3]); w.z = pk(f[4], f[5]); w.w = pk(f[6], f[7]);
            *(u32x4*)(dst + (size_t)drow * lddst + k0 + k8) = w; }
        __syncthreads();
    }
    const int gt = bid * 512 + tid, gn = nb * 512;
    { const float* x = p.in[0]; bf16_t* xb = (bf16_t*)(ws + WS_XB);
      for (int i = gt; i < MTOK * 1024 / 8; i += gn) { const float4 a = *(const float4*)(x + (size_t)i * 8), b = *(const float4*)(x + (size_t)i * 8 + 4);
          u32x4 w; w.x = pk(a.x, a.y); w.y = pk(a.z, a.w); w.z = pk(b.x, b.y); w.w = pk(b.z, b.w); *(u32x4*)(xb + (size_t)i * 8) = w; } }
    { float2* rope = (float2*)(ws + WS_ROPE);
      for (int idx = gt; idx < 4096 * 32; idx += gn) { const int pos = idx >> 5, i = idx & 31;
          double f = 1.0; for (int k = 0; k < i; ++k) f *= 0.7498942093324559;
          const float inv = (float)f; const float ang = (float)pos * inv;
          const double a = (double)ang; const double nrev = rint(a * 0.15915494309189535); const double rr = (a - nrev * 6.283185307179586) * 0.25;
          const double r2 = rr * rr;
          double s = rr * (1.0 + r2 * (-1.0 / 6 + r2 * (1.0 / 120 + r2 * (-1.0 / 5040 + r2 * (1.0 / 362880 + r2 * (-1.0 / 39916800))))));
          double c = 1.0 + r2 * (-0.5 + r2 * (1.0 / 24 + r2 * (-1.0 / 720 + r2 * (1.0 / 40320 + r2 * (-1.0 / 3628800 + r2 * (1.0 / 479001600))))));
          double s2 = 2 * s * c, c2 = c * c - s * s; s = 2 * s2 * c2; c = c2 * c2 - s2 * s2;
          rope[idx] = make_float2((float)c, (float)s); } }
    { float4* lc = (float4*)(ws + WS_LRUC);
      for (int idx = gt; idx < NL * 2 * 384; idx += gn) { const float ba = p.in[5][idx], bx = p.in[7][idx], lam = p.in[8][idx];
          const float nl = -lam; const float sp = fmaxf(nl, 0.f) + log1pf(expf(-fabsf(nl)));
          lc[idx] = make_float4(-8.0f * sp * 1.4426950408889634f, -1.4426950408889634f * ba, -1.4426950408889634f * bx, 0.f); } }
    { bf16_t* wt = (bf16_t*)(ws + WS_LRUW);
      for (int idx = gt; idx < NL * 2 * 2 * 6 * 64 * 8; idx += gn) { const int c8 = idx & 7, o = (idx >> 3) & 63, mat = idx >> 9;
          const int g = mat % 6, kind = (mat / 6) & 1, dir = (mat / 12) & 1, l = mat / 24;
          const float* src = (kind ? p.in[6] : p.in[4]) + ((size_t)((l * 2 + dir) * 6 + g) * 64 + c8 * 8) * 64 + o; float f[8];
#pragma unroll
          for (int j = 0; j < 8; ++j) f[j] = src[j * 64];
          u32x4 w; w.x = pk(f[0], f[1]); w.y = pk(f[2], f[3]); w.z = pk(f[4], f[5]); w.w = pk(f[6], f[7]);
          *(u32x4*)(wt + (size_t)mat * 4096 + o * 64 + c8 * 8) = w; } }
}

__device__ void phase_ln(const float* xin, const bf16_t* br, const float* g, const float* bta, float* xo, bf16_t* xb) {
    const int tid = tidx(), lane = tid & 63, wid = tid >> 6;
    float4 gg[4], bb[4];
#pragma unroll
    for (int i = 0; i < 4; ++i) { gg[i] = ((const float4*)g)[lane + 64 * i]; bb[i] = ((const float4*)bta)[lane + 64 * i]; }
    const int rstep = gridDim.x * 8;
    int row = bidx() * 8 + wid;
    float4 nx[4]; u32x2 nb_[4];
    if (row < MTOK) {
#pragma unroll
        for (int i = 0; i < 4; ++i) { nx[i] = ((const float4*)(xin + (size_t)row * 1024))[lane + 64 * i]; nb_[i] = ((const u32x2*)(br + (size_t)row * 1024))[lane + 64 * i]; } }
    for (; row < MTOK; row += rstep) {
        float4 a[4]; float s = 0.f;
#pragma unroll
        for (int i = 0; i < 4; ++i) { const float4 x4 = nx[i]; const u32x2 b2 = nb_[i];
            a[i].x = x4.x * ALPHA + bflo(b2.x); a[i].y = x4.y * ALPHA + bfhi(b2.x); a[i].z = x4.z * ALPHA + bflo(b2.y); a[i].w = x4.w * ALPHA + bfhi(b2.y);
            s += (a[i].x + a[i].y) + (a[i].z + a[i].w); }
        const int rn = row + rstep;
        if (rn < MTOK) {
#pragma unroll
            for (int i = 0; i < 4; ++i) { nx[i] = ((const float4*)(xin + (size_t)rn * 1024))[lane + 64 * i]; nb_[i] = ((const u32x2*)(br + (size_t)rn * 1024))[lane + 64 * i]; } }
#pragma unroll
        for (int o = 32; o >= 1; o >>= 1) s += __shfl_xor(s, o);
        const float mu = s * (1.0f / 1024.0f); float q = 0.f;
#pragma unroll
        for (int i = 0; i < 4; ++i) { a[i].x -= mu; a[i].y -= mu; a[i].z -= mu; a[i].w -= mu; q += (a[i].x * a[i].x + a[i].y * a[i].y) + (a[i].z * a[i].z + a[i].w * a[i].w); }
#pragma unroll
        for (int o = 32; o >= 1; o >>= 1) q += __shfl_xor(q, o);
        const float rstd = rsqrtf(q * (1.0f / 1024.0f) + 1e-5f);
#pragma unroll
        for (int i = 0; i < 4; ++i) { float4 y; y.x = a[i].x * rstd * gg[i].x + bb[i].x; y.y = a[i].y * rstd * gg[i].y + bb[i].y; y.z = a[i].z * rstd * gg[i].z + bb[i].z; y.w = a[i].w * rstd * gg[i].w + bb[i].w;
            ((float4*)(xo + (size_t)row * 1024))[lane + 64 * i] = y;
            if (xb) { u32x2 w; w.x = pk(y.x, y.y); w.y = pk(y.z, y.w); *(u32x2*)(xb + (size_t)row * 1024 + (lane + 64 * i) * 4) = w; } }
    }
}

typedef short v4i16_t __attribute__((ext_vector_type(4)));
constexpr int NSTR = 72;
constexpr float LOG2E = 1.4426950408889634f;
__device__ __forceinline__ bf16x8 tr8(const bf16_t* p0) {
    const v4i16_t a = __builtin_amdgcn_ds_read_tr16_b64_v4i16((LAS v4i16_t*)p0);
    const v4i16_t b = __builtin_amdgcn_ds_read_tr16_b64_v4i16((LAS v4i16_t*)(p0 + 4 * NSTR));
    return __builtin_shufflevector(a, b, 0, 1, 2, 3, 4, 5, 6, 7);
}

struct NatRegs { u32x4 v[9]; };
__device__ __forceinline__ void nat_geom(int item, int& b, int& h, int& r0, int& rs0, int& rs1, int& nrows) {
    const int rp = item & 31; h = (item >> 5) & 3; b = item >> 7; r0 = 2 * rp; rs0 = clampi(r0 - 4, 0, 56); rs1 = clampi(r0 - 3, 0, 56); nrows = rs1 + 8 - rs0;
}
__device__ __forceinline__ void nat_load(NatRegs& R, const bf16_t* proj, int item, int tid) {
    int b, h, r0, rs0, rs1, nrows; nat_geom(item, b, h, r0, rs0, rs1, nrows);
    const bf16_t* vbase = proj + ((size_t)b * 4096 + rs0 * 64) * 3072 + 2816 + h * 64;
#pragma unroll
    for (int i = 0; i < 9; ++i) { const int idx = tid + 512 * i, key = idx >> 3, ds = idx & 7;
        if (i < 8 || nrows == 9) R.v[i] = *(const u32x4*)(vbase + (size_t)key * 3072 + ds * 8); }
}
__device__ __forceinline__ void nat_store(const NatRegs& R, bf16_t* V, int item, int tid) {
    int b, h, r0, rs0, rs1, nrows; nat_geom(item, b, h, r0, rs0, rs1, nrows);
#pragma unroll
    for (int i = 0; i < 9; ++i) { const int idx = tid + 512 * i, key = idx >> 3, ds = idx & 7;
        if (i < 8 || nrows == 9) *(u32x4*)(V + key * NSTR + ds * 8) = R.v[i]; }
}
__device__ __forceinline__ void nat_compute(const bf16_t* proj, bf16_t* y, const bf16_t* V, const float* rpball, int item, int tid) {
    const int wid = tid >> 6, lane = tid & 63, fr = lane & 15, fq = lane >> 4;
    int b, h, r0, rs0, rs1, nrows; nat_geom(item, b, h, r0, rs0, rs1, nrows);
    const float* rpb = rpball + h * 465; const int rbase = rs0;
    const int rsel = wid >> 2, n = wid & 3, r = r0 + rsel, rs = rsel ? rs1 : rs0, c0 = n * 16, ss = clampi(c0 - 8, 0, 32);
    const bf16_t* qp = proj + ((size_t)b * 4096 + r * 64 + c0 + fr) * 3072 + 2304 + h * 64 + fq * 8;
    const bf16x8 q0 = *(const bf16x8*)qp, q1 = *(const bf16x8*)(qp + 32);
    f32x4 s[8][2];
#pragma unroll
    for (int kr = 0; kr < 8; ++kr)
#pragma unroll
        for (int t = 0; t < 2; ++t) { const int kcol = ss + (fr >> 2) * 8 + 4 * t + (fr & 3);
            const bf16_t* kp = proj + ((size_t)b * 4096 + (rs + kr) * 64 + kcol) * 3072 + 2560 + h * 64 + fq * 8;
            const bf16x8 k0 = *(const bf16x8*)kp, k1 = *(const bf16x8*)(kp + 32);
            f32x4 a = {0.f, 0.f, 0.f, 0.f}; a = mfma16(k0, q0, a); a = mfma16(k1, q1, a); s[kr][t] = a;
            if (kr == 3 && t == 1) asm volatile("" ::: "memory"); }
    const int qc = c0 + fr, cst = clampi(qc - 8, 0, 48);
    float mx = -3.0e38f;
#pragma unroll
    for (int kr = 0; kr < 8; ++kr) { const int ri = rs + kr - r + 7;
#pragma unroll
        for (int t = 0; t < 2; ++t)
#pragma unroll
            for (int e = 0; e < 4; ++e) { const int kc = ss + fq * 8 + 4 * t + e; const bool valid = (kc >= cst) && (kc < cst + 16);
                const int ci = clampi(kc - qc, -15, 15) + 15;
                const float v = valid ? s[kr][t][e] * 0.125f + rpb[ri * 31 + ci] : -3.0e38f; s[kr][t][e] = v; mx = fmaxf(mx, v); } }
    mx = fmaxf(mx, __shfl_xor(mx, 16)); mx = fmaxf(mx, __shfl_xor(mx, 32));
    float sum = 0.f;
#pragma unroll
    for (int kr = 0; kr < 8; ++kr)
#pragma unroll
        for (int t = 0; t < 2; ++t)
#pragma unroll
            for (int e = 0; e < 4; ++e) { const float v = s[kr][t][e]; const float pe = (v > -1.0e38f) ? __expf(v - mx) : 0.f; s[kr][t][e] = pe; sum += pe; }
    sum += __shfl_xor(sum, 16); sum += __shfl_xor(sum, 32);
    const float inv = 1.0f / sum;
    f32x4 o[4];
#pragma unroll
    for (int dt = 0; dt < 4; ++dt) o[dt] = (f32x4){0.f, 0.f, 0.f, 0.f};
#pragma unroll
    for (int kr = 0; kr < 8; ++kr) { u32x4 pw; pw.x = pk(s[kr][0][0] * inv, s[kr][0][1] * inv); pw.y = pk(s[kr][0][2] * inv, s[kr][0][3] * inv);
        pw.z = pk(s[kr][1][0] * inv, s[kr][1][1] * inv); pw.w = pk(s[kr][1][2] * inv, s[kr][1][3] * inv); const bf16x8 pf = as_frag(pw);
        const bf16_t* vrow = V + ((rs + kr - rbase) * 64 + ss + fq * 8 + (fr >> 2)) * NSTR + (fr & 3) * 4;
#pragma unroll
        for (int dt = 0; dt < 4; ++dt) { const bf16x8 vf = tr8(vrow + dt * 16); o[dt] = mfma16(vf, pf, o[dt]); } }
    bf16_t* yp = y + ((size_t)b * 4096 + r * 64 + c0 + fr) * 1024 + 768 + h * 64 + fq * 4;
#pragma unroll
    for (int dt = 0; dt < 4; ++dt) { u32x2 w; w.x = pk(o[dt][0], o[dt][1]); w.y = pk(o[dt][2], o[dt][3]); *(u32x2*)(yp + dt * 16) = w; }
}

struct RetRegs { u32x4 qlo, qhi, klo, khi, v0, v1; float4 cs[4]; };
template <bool WITHQ>
__device__ __forceinline__ void ret_load(RetRegs& R, const bf16_t* proj, const float2* rope, int item, int tid) {
    const int n = item & 31, h = (item >> 5) % 6, b = item / 192, j = tid >> 2, ds = tid & 3, pos = n * 128 + j; const size_t tok = (size_t)b * 4096 + pos;
    const bf16_t* kp = proj + tok * 3072 + 1152 + h * 64 + ds * 8;
    R.klo = *(const u32x4*)kp; R.khi = *(const u32x4*)(kp + 32);
    if (WITHQ) { R.qlo = *(const u32x4*)(kp - 384); R.qhi = *(const u32x4*)(kp - 384 + 32); }
    const bf16_t* vp = proj + tok * 3072 + 1536 + h * 64 + ds * 16; R.v0 = *(const u32x4*)vp; R.v1 = *(const u32x4*)(vp + 8);
    const float4* cs = (const float4*)(rope + pos * 32 + ds * 8);
#pragma unroll
    for (int i = 0; i < 4; ++i) R.cs[i] = cs[i];
}
__device__ __forceinline__ void rope8(const u32x4& lo, const u32x4& hi, const float4 (&cs)[4], float s1, float s2, u32x4& o1a, u32x4& o2a, u32x4& o1b, u32x4& o2b) {
    float a1[8], a2[8];
#pragma unroll
    for (int jp = 0; jp < 4; ++jp)
#pragma unroll
        for (int hh = 0; hh < 2; ++hh) { const int jj = jp * 2 + hh; const float c = hh ? cs[jp].z : cs[jp].x, sn = hh ? cs[jp].w : cs[jp].y;
            const float t1 = BFEL(lo, jj), t2 = BFEL(hi, jj); a1[jj] = t1 * c - t2 * sn; a2[jj] = t1 * sn + t2 * c; }
    o1a.x = pk(a1[0] * s1, a1[1] * s1); o1a.y = pk(a1[2] * s1, a1[3] * s1); o1a.z = pk(a1[4] * s1, a1[5] * s1); o1a.w = pk(a1[6] * s1, a1[7] * s1);
    o2a.x = pk(a2[0] * s1, a2[1] * s1); o2a.y = pk(a2[2] * s1, a2[3] * s1); o2a.z = pk(a2[4] * s1, a2[5] * s1); o2a.w = pk(a2[6] * s1, a2[7] * s1);
    o1b.x = pk(a1[0] * s2, a1[1] * s2); o1b.y = pk(a1[2] * s2, a1[3] * s2); o1b.z = pk(a1[4] * s2, a1[5] * s2); o1b.w = pk(a1[6] * s2, a1[7] * s2);
    o2b.x = pk(a2[0] * s2, a2[1] * s2); o2b.y = pk(a2[2] * s2, a2[3] * s2); o2b.z = pk(a2[4] * s2, a2[5] * s2); o2b.w = pk(a2[6] * s2, a2[7] * s2);
}
__device__ __forceinline__ void ret_a_store(const RetRegs& R, bf16_t* lds, int item, int tid) {
    const int h = (item >> 5) % 6, j = tid >> 2, ds = tid & 3; const float l2g = log2gamma(h);
    bf16_t* Kf = lds; bf16_t* Kb = Kf + 128 * NSTR; bf16_t* V = Kb + 128 * NSTR;
    const float wf = __builtin_amdgcn_exp2f((float)(127 - j) * l2g) * 0.125f, wb = __builtin_amdgcn_exp2f((float)j * l2g) * 0.125f;
    u32x4 f1, f2, b1, b2; rope8(R.klo, R.khi, R.cs, wf, wb, f1, f2, b1, b2);
    *(u32x4*)(Kf + j * NSTR + ds * 8) = f1; *(u32x4*)(Kf + j * NSTR + 32 + ds * 8) = f2;
    *(u32x4*)(Kb + j * NSTR + ds * 8) = b1; *(u32x4*)(Kb + j * NSTR + 32 + ds * 8) = b2;
    *(u32x4*)(V + j * NSTR + ds * 16) = R.v0; *(u32x4*)(V + j * NSTR + ds * 16 + 8) = R.v1;
}
__device__ __forceinline__ void ret_a_compute(float* kv, const bf16_t* lds, int item, int tid) {
    const int wid = tid >> 6, lane = tid & 63, fr = lane & 15, fq = lane >> 4;
    const bf16_t* Kf = lds; const bf16_t* Kb = Kf + 128 * NSTR; const bf16_t* V = Kb + 128 * NSTR;
    const int et = wid >> 1, lo = (fq * 8 + (fr >> 2)) * NSTR + (fr & 3) * 4;
#pragma unroll
    for (int dd = 0; dd < 2; ++dd) { const int dt = (wid & 1) * 2 + dd; f32x4 af = {0.f, 0.f, 0.f, 0.f}, ab = {0.f, 0.f, 0.f, 0.f};
#pragma unroll
        for (int js = 0; js < 4; ++js) { const int ro = js * 32 * NSTR + lo;
            const bf16x8 A = tr8(V + ro + et * 16), Bf = tr8(Kf + ro + dt * 16), Bb = tr8(Kb + ro + dt * 16);
            af = mfma16(A, Bf, af); ab = mfma16(A, Bb, ab); }
        float* o = kv + (size_t)item * 2 * 4096 + (et * 16 + fq * 4) * 64 + dt * 16 + fr;
#pragma unroll
        for (int x = 0; x < 4; ++x) { o[x * 64] = af[x]; o[4096 + x * 64] = ab[x]; } }
}
__device__ __forceinline__ void ret_c_store(const RetRegs& R, bf16_t* lds, int tid) {
    const int j = tid >> 2, ds = tid & 3;
    bf16_t* Qr = lds; bf16_t* Kr = Qr + 128 * NSTR; bf16_t* V = Kr + 128 * NSTR;
    u32x4 q1, q2, k1, k2, d1, d2; rope8(R.qlo, R.qhi, R.cs, 1.0f, 1.0f, q1, q2, d1, d2); rope8(R.klo, R.khi, R.cs, 0.125f, 0.125f, k1, k2, d1, d2);
    *(u32x4*)(Qr + j * NSTR + ds * 8) = q1; *(u32x4*)(Qr + j * NSTR + 32 + ds * 8) = q2;
    *(u32x4*)(Kr + j * NSTR + ds * 8) = k1; *(u32x4*)(Kr + j * NSTR + 32 + ds * 8) = k2;
    *(u32x4*)(V + j * NSTR + ds * 16) = R.v0; *(u32x4*)(V + j * NSTR + ds * 16 + 8) = R.v1;
}
__device__ __forceinline__ void ret_c_compute(const bf16_t* proj, const bf16_t* st, const float* gnw, bf16_t* y, const bf16_t* lds, int item, int tid) {
    const int wid = tid >> 6, lane = tid & 63, fr = lane & 15, fq = lane >> 4;
    const int n = item & 31, h = (item >> 5) % 6, b = item / 192; const float l2g = log2gamma(h);
    const bf16_t* Qr = lds; const bf16_t* Kr = Qr + 128 * NSTR; const bf16_t* V = Kr + 128 * NSTR;
    const int it = wid, il = it * 16 + fr;
    const bf16x8 Qb0 = *(const bf16x8*)(Qr + il * NSTR + fq * 8), Qb1 = *(const bf16x8*)(Qr + il * NSTR + 32 + fq * 8);
    f32x4 ot[4];
#pragma unroll
    for (int et = 0; et < 4; ++et) ot[et] = (f32x4){0.f, 0.f, 0.f, 0.f};
    const int lo = (fq * 8 + (fr >> 2)) * NSTR + (fr & 3) * 4;
#pragma unroll
    for (int jg = 0; jg < 4; ++jg) { float pv[8];
#pragma unroll
        for (int t = 0; t < 2; ++t) { const int jrow = jg * 32 + (fr >> 2) * 8 + 4 * t + (fr & 3);
            const bf16x8 A0 = *(const bf16x8*)(Kr + jrow * NSTR + fq * 8), A1 = *(const bf16x8*)(Kr + jrow * NSTR + 32 + fq * 8);
            f32x4 s = {0.f, 0.f, 0.f, 0.f}; s = mfma16(A0, Qb0, s); s = mfma16(A1, Qb1, s);
#pragma unroll
            for (int e = 0; e < 4; ++e) { const int jj = jg * 32 + fq * 8 + 4 * t + e; const int dist = il > jj ? il - jj : jj - il;
                pv[t * 4 + e] = s[e] * __builtin_amdgcn_exp2f((float)dist * l2g); } }
        u32x4 pw; pw.x = pk(pv[0], pv[1]); pw.y = pk(pv[2], pv[3]); pw.z = pk(pv[4], pv[5]); pw.w = pk(pv[6], pv[7]); const bf16x8 pf = as_frag(pw);
#pragma unroll
        for (int et = 0; et < 4; ++et) { const bf16x8 vf = tr8(V + jg * 32 * NSTR + lo + et * 16); ot[et] = mfma16(vf, pf, ot[et]); } }
    const bf16_t* stf = st + (size_t)item * 2 * 4096; const bf16_t* stb = stf + 4096;
    const float wfi = __builtin_amdgcn_exp2f((float)(il + 1) * l2g), wbi = __builtin_amdgcn_exp2f((float)(128 - il) * l2g);
    float sum = 0.f;
#pragma unroll
    for (int et = 0; et < 4; ++et) { f32x4 af = {0.f, 0.f, 0.f, 0.f}, ab = {0.f, 0.f, 0.f, 0.f};
        const bf16_t* pf0 = stf + (et * 16 + fr) * 64 + fq * 8; const bf16_t* pb0 = stb + (et * 16 + fr) * 64 + fq * 8;
        af = mfma16(*(const bf16x8*)pf0, Qb0, af); af = mfma16(*(const bf16x8*)(pf0 + 32), Qb1, af);
        ab = mfma16(*(const bf16x8*)pb0, Qb0, ab); ab = mfma16(*(const bf16x8*)(pb0 + 32), Qb1, ab);
        ot[et] = ot[et] + af * wfi + ab * wbi; sum += (ot[et][0] + ot[et][1]) + (ot[et][2] + ot[et][3]); }
    sum += __shfl_xor(sum, 16); sum += __shfl_xor(sum, 32);
    const float mu = sum * (1.0f / 64.0f); float q = 0.f;
#pragma unroll
    for (int et = 0; et < 4; ++et) { ot[et] = ot[et] - mu; q += (ot[et][0] * ot[et][0] + ot[et][1] * ot[et][1]) + (ot[et][2] * ot[et][2] + ot[et][3] * ot[et][3]); }
    q += __shfl_xor(q, 16); q += __shfl_xor(q, 32);
    const float rstd = rsqrtf(q * (1.0f / 64.0f) + 1e-6f);
    const size_t tok = (size_t)b * 4096 + n * 128 + il;
    const bf16_t* gp = proj + tok * 3072 + 1920 + h * 64 + fq * 4; bf16_t* yp = y + tok * 1024 + 384 + h * 64 + fq * 4; const float* gw = gnw + h * 64 + fq * 4;
#pragma unroll
    for (int et = 0; et < 4; ++et) { const u32x2 gv = *(const u32x2*)(gp + et * 16); const f32x4 w4 = *(const f32x4*)(gw + et * 16);
        const float g0 = bflo(gv.x), g1 = bfhi(gv.x), g2 = bflo(gv.y), g3 = bfhi(gv.y);
        const float o0 = ot[et][0] * rstd * w4[0] * (g0 * sigm(g0)), o1 = ot[et][1] * rstd * w4[1] * (g1 * sigm(g1));
        const float o2 = ot[et][2] * rstd * w4[2] * (g2 * sigm(g2)), o3 = ot[et][3] * rstd * w4[3] * (g3 * sigm(g3));
        u32x2 w; w.x = pk(o0, o1); w.y = pk(o2, o3); *(u32x2*)(yp + et * 16) = w; }
}

template <bool FINAL>
__device__ void lru_item(const Params& p, int l, int item, int lane, const bf16_t* Wl, const bf16_t* Xl, int chl) {
    const int g = item % 6, ch = (item / 6) & 127, b = item / 768, fr = lane & 15, fq = lane >> 4;
    const bf16_t* proj = (const bf16_t*)(p.ws + WS_R1);
    const float* cw = p.in[2] + l * 4 * 384; const float* cb = p.in[3] + l * 384;
    const int t0 = ch * 32;
    bf16x8 A[2][2];
#pragma unroll
    for (int ks = 0; ks < 2; ++ks) { const int c = g * 64 + ks * 32 + fq * 8; float w[4][8], bias[8];
#pragma unroll
        for (int tap = 0; tap < 4; ++tap) { const float4 w0 = *(const float4*)(cw + tap * 384 + c), w1 = *(const float4*)(cw + tap * 384 + c + 4);
            w[tap][0] = w0.x; w[tap][1] = w0.y; w[tap][2] = w0.z; w[tap][3] = w0.w; w[tap][4] = w1.x; w[tap][5] = w1.y; w[tap][6] = w1.z; w[tap][7] = w1.w; }
        { const float4 b0 = *(const float4*)(cb + c), b1 = *(const float4*)(cb + c + 4);
          bias[0] = b0.x; bias[1] = b0.y; bias[2] = b0.z; bias[3] = b0.w; bias[4] = b1.x; bias[5] = b1.y; bias[6] = b1.z; bias[7] = b1.w; }
#pragma unroll
        for (int tt = 0; tt < 2; ++tt) { const int t = t0 + tt * 16 + fr; float acc[8];
#pragma unroll
            for (int jj = 0; jj < 8; ++jj) acc[jj] = bias[jj];
#pragma unroll
            for (int tap = 0; tap < 4; ++tap) { const u32x4 v = *(const u32x4*)(Xl + (chl * 32 + tt * 16 + fr + tap) * NSTR + ks * 32 + fq * 8);
#pragma unroll
                for (int jj = 0; jj < 8; ++jj) acc[jj] += BFEL(v, jj) * w[tap][jj]; }
            u32x4 pw; pw.x = pk(acc[0], acc[1]); pw.y = pk(acc[2], acc[3]); pw.z = pk(acc[4], acc[5]); pw.w = pk(acc[6], acc[7]); A[tt][ks] = as_frag(pw); } }
#pragma unroll 1
    for (int ot = 0; ot < 4; ++ot) {
        const int o = ot * 16 + fr, cgi = g * 64 + o;
        int tokb = b * 4096 + t0 + fq * 4; unsigned gtv[2][4];
        if (FINAL) { asm volatile("" : "+v"(tokb));
#pragma unroll
            for (int tt = 0; tt < 2; ++tt)
#pragma unroll
                for (int e = 0; e < 4; ++e) gtv[tt][e] = (unsigned)proj[(unsigned)(tokb + tt * 16 + e) * 3072u + 384u + (unsigned)cgi]; }
        f32x4 xcC[2];
        { u32x4 i0, i1;
#pragma unroll
          for (int dw = 0; dw < 4; ++dw) { const int m0 = o - fq * 8, m1 = o - 32 - fq * 8;
              i0[dw] = (m0 == 2 * dw ? 0x3F80u : 0u) | (m0 == 2 * dw + 1 ? 0x3F800000u : 0u);
              i1[dw] = (m1 == 2 * dw ? 0x3F80u : 0u) | (m1 == 2 * dw + 1 ? 0x3F800000u : 0u); }
          const bf16x8 I0 = as_frag(i0), I1 = as_frag(i1);
#pragma unroll
          for (int tt = 0; tt < 2; ++tt) { f32x4 a = {0.f, 0.f, 0.f, 0.f}; a = mfma16(A[tt][0], I0, a); a = mfma16(A[tt][1], I1, a); xcC[tt] = a; } }
        float hs[2][4];
#pragma unroll
        for (int tt = 0; tt < 2; ++tt)
#pragma unroll
            for (int e = 0; e < 4; ++e) hs[tt][e] = 0.f;
#pragma unroll
        for (int dir = 0; dir < 2; ++dir) {
            const bf16_t* wa = Wl + ((dir * 2 + 0) * 64 + o) * NSTR + fq * 8; const bf16_t* wx = wa + 64 * NSTR;
            const bf16x8 Ba0 = *(const bf16x8*)wa, Ba1 = *(const bf16x8*)(wa + 32), Bx0 = *(const bf16x8*)wx, Bx1 = *(const bf16x8*)(wx + 32);
            const int pi = (l * 2 + dir) * 384 + cgi;
            const float4 lc4 = ((const float4*)(p.ws + WS_LRUC))[pi];
            const float cr = lc4.x, nba = lc4.y, nbx = lc4.z;
            const size_t aidx = ((size_t)(b * 128 + ch) * 2 + dir) * 384 + cgi;
            float Hc = 0.f, Acc = 1.f;
            if (FINAL) Hc = ((const float*)(p.ws + WS_CARRY))[aidx];
#pragma unroll
            for (int step = 0; step < 2; ++step) { const int tt = dir ? 1 - step : step;
                f32x4 pa = {0.f, 0.f, 0.f, 0.f}, px = {0.f, 0.f, 0.f, 0.f};
                pa = mfma16(A[tt][0], Ba0, pa); pa = mfma16(A[tt][1], Ba1, pa); px = mfma16(A[tt][0], Bx0, px); px = mfma16(A[tt][1], Bx1, px);
                float av[4], uv[4];
#pragma unroll
                for (int e = 0; e < 4; ++e) { const float r = __builtin_amdgcn_rcpf(1.0f + __builtin_amdgcn_exp2f(fmaf(pa[e], -LOG2E, nba)));
                    const float ii = __builtin_amdgcn_rcpf(1.0f + __builtin_amdgcn_exp2f(fmaf(px[e], -LOG2E, nbx)));
                    const float a = __builtin_amdgcn_exp2f(cr * r); const float em = fmaxf(fmaf(-a, a, 1.0f), 0.f);
                    av[e] = a; uv[e] = __builtin_amdgcn_sqrtf(em) * ii * xcC[tt][e]; }
                float Aq, Uq;
                if (dir == 0) { Aq = av[0]; Uq = uv[0];
#pragma unroll
                    for (int e = 1; e < 4; ++e) { Uq = av[e] * Uq + uv[e]; Aq *= av[e]; } }
                else { Aq = av[3]; Uq = uv[3];
#pragma unroll
                    for (int e = 2; e >= 0; --e) { Uq = av[e] * Uq + uv[e]; Aq *= av[e]; } }
                float Aall[4], Uall[4];
#pragma unroll
                for (int q = 0; q < 4; ++q) { Aall[q] = __shfl(Aq, q * 16 + fr); Uall[q] = __shfl(Uq, q * 16 + fr); }
                float hq = Hc, hh = Hc;
#pragma unroll
                for (int qq = 0; qq < 4; ++qq) { const int q = dir ? 3 - qq : qq; const bool before = dir ? (q > fq) : (q < fq);
                    if (before) hq = Aall[q] * hq + Uall[q];
                    hh = Aall[q] * hh + Uall[q]; Acc *= Aall[q]; }
                Hc = hh;
                if (FINAL) {
                    if (dir == 0) {
#pragma unroll
                        for (int e = 0; e < 4; ++e) { hq = av[e] * hq + uv[e]; hs[tt][e] += hq; } }
                    else {
#pragma unroll
                        for (int e = 3; e >= 0; --e) { hq = av[e] * hq + uv[e]; hs[tt][e] += hq; } }
                }
            }
            if (!FINAL) { if (fq == 0) ((float2*)(p.ws + WS_AGG))[aidx] = make_float2(Acc, Hc); }
        }
        if (FINAL) { bf16_t* y = (bf16_t*)(p.ws + WS_Y);
#pragma unroll
            for (int tt = 0; tt < 2; ++tt)
#pragma unroll
                for (int e = 0; e < 4; ++e) { const unsigned tok = (unsigned)(tokb + tt * 16 + e);
                    const float gt = __uint_as_float(gtv[tt][e] << 16);
                    const float z = 0.7978845608028654f * (gt + 0.044715f * gt * gt * gt); const float th = 1.0f - 2.0f * __builtin_amdgcn_rcpf(1.0f + __builtin_amdgcn_exp2f(2.885390081777927f * z));
                    y[tok * 1024u + (unsigned)cgi] = f2bf(hs[tt][e] * 0.5f * gt * (1.0f + th)); } }
    }
}

__device__ __forceinline__ void lru_stage_w(const Params& p, int l, int g, bf16_t* Wl, int tid) {
    const bf16_t* lw = (const bf16_t*)(p.ws + WS_LRUW);
#pragma unroll
    for (int i = 0; i < 4; ++i) { const int idx = tid + 512 * i, mat = idx >> 9, o = (idx >> 3) & 63, c8 = idx & 7;
        const u32x4 v = *(const u32x4*)(lw + (size_t)(((l * 2 + (mat >> 1)) * 2 + (mat & 1)) * 6 + g) * 4096 + o * 64 + c8 * 8);
        *(u32x4*)(Wl + (mat * 64 + o) * NSTR + c8 * 8) = v; }
}
struct LruX { u32x4 v[5]; };
__device__ __forceinline__ void lru_xload(LruX& R, const Params& p, int T, int tid) {
    const bf16_t* proj = (const bf16_t*)(p.ws + WS_R1);
    const int g = T % 6, rest = T / 6, b = rest >> 4, tb = (rest & 15) * 256 - 2;
#pragma unroll
    for (int i = 0; i < 5; ++i) { const int idx = tid + 512 * i, row = idx >> 3, c8 = idx & 7, tok = tb + row; R.v[i] = (u32x4){0u, 0u, 0u, 0u};
        if (row < 259 && tok >= 0 && tok < SEQ) R.v[i] = *(const u32x4*)(proj + ((size_t)b * 4096 + tok) * 3072 + g * 64 + c8 * 8); }
}
__device__ __forceinline__ void lru_xstore(const LruX& R, bf16_t* Xl, int tid) {
#pragma unroll
    for (int i = 0; i < 5; ++i) { const int idx = tid + 512 * i, row = idx >> 3, c8 = idx & 7; if (row < 259) *(u32x4*)(Xl + row * NSTR + c8 * 8) = R.v[i]; }
}
__device__ void phase_mix_a(const Params& p, int l, unsigned char* ldsg) {
    const int tid = tidx(), nb = gridDim.x, rb_ = bidx(), bid = (nb % 8 == 0) ? (rb_ & 7) * (nb >> 3) + (rb_ >> 3) : rb_;
    const bf16_t* proj = (const bf16_t*)(p.ws + WS_R1);
    float* rp = (float*)(ldsg + 83968);
    { const float* src = p.in[10] + l * 1860; for (int i = tid; i < 1860; i += 512) rp[i] = src[i]; }
    { NatRegs R; int t = bid; if (t < 1024) nat_load(R, proj, t, tid);
      for (; t < 1024; t += nb) { nat_store(R, (bf16_t*)ldsg, t, tid); __syncthreads();
          const int tn = t + nb; if (tn < 1024) nat_load(R, proj, tn, tid);
          nat_compute(proj, (bf16_t*)(p.ws + WS_Y), (const bf16_t*)ldsg, rp, t, tid); __syncthreads(); } }
    { RetRegs R; int t = bid; const float2* rope = (const float2*)(p.ws + WS_ROPE); if (t < 1536) ret_load<false>(R, proj, rope, t, tid);
      for (; t < 1536; t += nb) { ret_a_store(R, (bf16_t*)ldsg, t, tid); __syncthreads();
          const int tn = t + nb; if (tn < 1536) ret_load<false>(R, proj, rope, tn, tid);
          ret_a_compute((float*)(p.ws + WS_KV), (const bf16_t*)ldsg, t, tid); __syncthreads(); } }
    { LruX XR; int t = bid; if (t < 768) lru_xload(XR, p, t, tid);
      for (; t < 768; t += nb) {
        const int g = t % 6, rest = t / 6, b = rest >> 4, ch = (rest & 15) * 8 + (tid >> 6);
        lru_stage_w(p, l, g, (bf16_t*)ldsg, tid); lru_xstore(XR, (bf16_t*)(ldsg + 40192), tid); __syncthreads();
        if (t + nb < 768) lru_xload(XR, p, t + nb, tid);
        lru_item<false>(p, l, (b * 128 + ch) * 6 + g, tid & 63, (const bf16_t*)ldsg, (const bf16_t*)(ldsg + 40192), tid >> 6); __syncthreads(); } }
}
__device__ void phase_mix_b(const Params& p, unsigned char* ldsg) {
    const int tid = tidx(), nb = gridDim.x, bid = bidx();
    for (int t = bid; t < 816; t += nb) {
        if (t >= 48) { const int u = t - 48;
            const int dir = u & 1, blk = (u >> 1) & 7, bh = u >> 4; const int h = bh % 6; const int el = blk * 512 + tid;
            const float gch = exp2f(128.0f * log2gamma(h));
            const float* kv = (const float*)(p.ws + WS_KV) + ((size_t)bh * 32 * 2 + dir) * 4096 + el; bf16_t* st = (bf16_t*)(p.ws + WS_ST) + ((size_t)bh * 32 * 2 + dir) * 4096 + el;
            float s = 0.f;
            if (dir == 0) {
#pragma unroll
                for (int n = 0; n < 32; ++n) { st[(size_t)n * 8192] = f2bf(s); s = gch * s + kv[(size_t)n * 8192]; } }
            else {
#pragma unroll
                for (int n = 31; n >= 0; --n) { st[(size_t)n * 8192] = f2bf(s); s = gch * s + kv[(size_t)n * 8192]; } }
        } else {
            const int seg = tid >> 7, sq = t * 128 + (tid & 127), c = sq % 384, dir = (sq / 384) & 1, b = sq / 768;
            const float2* agg = (const float2*)(p.ws + WS_AGG); float* carry = (float*)(p.ws + WS_CARRY); float2* xs = (float2*)ldsg;
            float2 au[32];
#pragma unroll
            for (int k = 0; k < 32; ++k) { const int pos = seg * 32 + k, ch = dir ? 127 - pos : pos; au[k] = agg[((size_t)(b * 128 + ch) * 2 + dir) * 384 + c]; }
            float As = 1.f, Us = 0.f;
#pragma unroll
            for (int k = 0; k < 32; ++k) { Us = au[k].x * Us + au[k].y; As *= au[k].x; }
            xs[seg * 128 + (tid & 127)] = make_float2(As, Us);
            __syncthreads();
            float hcur = 0.f;
#pragma unroll
            for (int s2 = 0; s2 < 3; ++s2) if (s2 < seg) { const float2 e = xs[s2 * 128 + (tid & 127)]; hcur = e.x * hcur + e.y; }
#pragma unroll
            for (int k = 0; k < 32; ++k) { const int pos = seg * 32 + k, ch = dir ? 127 - pos : pos; carry[((size_t)(b * 128 + ch) * 2 + dir) * 384 + c] = hcur; hcur = au[k].x * hcur + au[k].y; }
            __syncthreads();
        }
    }
}
__device__ void phase_mix_c(const Params& p, int l, unsigned char* ldsg) {
    const int tid = tidx(), nb = gridDim.x, rb_ = bidx(), bid = (nb % 8 == 0) ? (rb_ & 7) * (nb >> 3) + (rb_ >> 3) : rb_;
    const bf16_t* proj = (const bf16_t*)(p.ws + WS_R1);
    { RetRegs R; int t = bid; const float2* rope = (const float2*)(p.ws + WS_ROPE); if (t < 1536) ret_load<true>(R, proj, rope, t, tid);
      for (; t < 1536; t += nb) { ret_c_store(R, (bf16_t*)ldsg, tid); __syncthreads();
          const int tn = t + nb; if (tn < 1536) ret_load<true>(R, proj, rope, tn, tid);
          ret_c_compute(proj, (const bf16_t*)(p.ws + WS_ST), p.in[9] + l * 384, (bf16_t*)(p.ws + WS_Y), (const bf16_t*)ldsg, t, tid); __syncthreads(); } }
    { LruX XR; int t = bid; if (t < 768) lru_xload(XR, p, t, tid);
      for (; t < 768; t += nb) {
        const int g = t % 6, rest = t / 6, b = rest >> 4, ch = (rest & 15) * 8 + (tid >> 6);
        lru_stage_w(p, l, g, (bf16_t*)ldsg, tid); lru_xstore(XR, (bf16_t*)(ldsg + 40192), tid); __syncthreads();
        if (t + nb < 768) lru_xload(XR, p, t + nb, tid);
        lru_item<true>(p, l, (b * 128 + ch) * 6 + g, tid & 63, (const bf16_t*)ldsg, (const bf16_t*)(ldsg + 40192), tid >> 6); __syncthreads(); } }
}

__device__ void run_phase(int ph, unsigned char* ldsg, LAS unsigned char* lds) {
    const Params __attribute__((address_space(4)))* kp = (const Params __attribute__((address_space(4)))*)__builtin_amdgcn_kernarg_segment_ptr();
    asm volatile("" : "+s"(kp));
    const Params& p = *(const Params*)kp;
    unsigned char* ws = p.ws;
    if (ph == 0) { phase_init(p, ldsg); return; }
    const int l = (ph - 1) / 9, s = (ph - 1) % 9;
    const int GBID = bidx();
    pg8::StaticOrder S;
    if (s == 0) { pg8::Gemm g{(const bf16_t*)(ws + WS_XB), (const bf16_t*)(ws + WS_WIN) + (size_t)l * 3072 * 1024, MTOK, 3072, 1024};
        S.init(MTOK, 3072, gridDim.x, GBID);
        EpiProj E{(bf16_t*)(ws + WS_R1), 3072}; pg8::gemm_phase<EpiProj, pg8::StaticOrder>(lds, g, S, E, nullptr); }
    else if (s == 1) phase_mix_a(p, l, ldsg);
    else if (s == 2) phase_mix_b(p, ldsg);
    else if (s == 3) phase_mix_c(p, l, ldsg);
    else if (s == 4) { pg8::Gemm g{(const bf16_t*)(ws + WS_Y), (const bf16_t*)(ws + WS_WOUT) + (size_t)l * 1024 * 1024, MTOK, 1024, 1024};
        S.init(MTOK, 1024, gridDim.x, GBID); EpiProj E{(bf16_t*)(ws + WS_XB), 1024}; pg8::gemm_phase<EpiProj, pg8::StaticOrder>(lds, g, S, E, nullptr); }
    else if (s == 5) phase_ln(l == 0 ? p.in[0] : p.out, (const bf16_t*)(ws + WS_XB), p.in[12] + l * 1024, p.in[13] + l * 1024, p.out, (bf16_t*)(ws + WS_XB));
    else if (s == 6) { pg8::Gemm g{(const bf16_t*)(ws + WS_XB), (const bf16_t*)(ws + WS_WGU) + (size_t)l * 5632 * 1024, MTOK, 5632, 1024};
        S.init(MTOK, 5632, gridDim.x, GBID);
        EpiSwiglu E{(bf16_t*)(ws + WS_R1)}; pg8::gemm_phase<EpiSwiglu, pg8::StaticOrder>(lds, g, S, E, nullptr); }
    else if (s == 7) { pg8::Gemm g{(const bf16_t*)(ws + WS_R1), (const bf16_t*)(ws + WS_WD) + (size_t)l * 1024 * 2816, MTOK, 1024, 2816};
        S.init(MTOK, 1024, gridDim.x, GBID); EpiProj E{(bf16_t*)(ws + WS_XB), 1024}; pg8::gemm_phase<EpiProj, pg8::StaticOrder>(lds, g, S, E, nullptr); }
    else if (s == 8) phase_ln(p.out, (const bf16_t*)(ws + WS_XB), p.in[17] + l * 1024, p.in[18] + l * 1024, p.out, l == NL - 1 ? nullptr : (bf16_t*)(ws + WS_XB));
}

#define XB_TMO      128
#define XB_XCNT(j)  (256  + 64 * (j))
#define XB_XSUB(j)  (1280 + 64 * (j))
#define XB_XGEN(j)  (2304 + 64 * (j))
#define XB_TOP      3328
#define XB_TOPGEN   3392
#define XCD_BAR_WORDS 3456
#define XB_SPIN_CAP (1u << 18)
__device__ __forceinline__ unsigned xb_ld(unsigned* p)              { return __hip_atomic_load(p, __ATOMIC_RELAXED, __HIP_MEMORY_SCOPE_AGENT); }
__device__ __forceinline__ unsigned xb_add(unsigned* p, unsigned v) { return __hip_atomic_fetch_add(p, v, __ATOMIC_RELAXED, __HIP_MEMORY_SCOPE_AGENT); }
__device__ __forceinline__ unsigned xb_xcc_id() { return (unsigned)__builtin_amdgcn_s_getreg((3 << 11) | 20) & 0xFu; }
#define XB_SPIN(cond, bar) do { unsigned _sp = 0; while (cond) { __builtin_amdgcn_s_sleep(1); \
    if ((++_sp & 255u) == 0u) { if (xb_ld(&(bar)[XB_TMO])) break; if (_sp > XB_SPIN_CAP) { atomicAdd(&(bar)[XB_TMO], 1u); break; } } } } while (0)
struct XcdBarrier { unsigned* bar; unsigned x; volatile LAS unsigned* st; };
__device__ __forceinline__ XcdBarrier xcd_barrier_post(unsigned* bar, volatile LAS unsigned* st) {
    XcdBarrier b; b.bar = bar; b.x = xb_xcc_id(); b.st = st;
    if (threadIdx.x == 0) (void)xb_add(&bar[XB_XCNT(b.x)], 1u);
    return b;
}
__device__ __forceinline__ void xcd_barrier_complete(unsigned* bar, unsigned x, unsigned& nloc, unsigned& nx) {
    const unsigned G = gridDim.x * gridDim.y * gridDim.z;
    unsigned sum, cnt, mine, sp = 0u;
    for (;;) {
        sum = 0u; cnt = 0u; mine = 0u;
#pragma unroll
        for (unsigned j = 0; j < 16; ++j) { const unsigned c = xb_ld(&bar[XB_XCNT(j)]); sum += c; cnt += (c > 0u) ? 1u : 0u; mine = (j == x) ? c : mine; }
        if (sum == G) break;
        __builtin_amdgcn_s_sleep(1);
        if ((++sp & 255u) == 0u) { if (xb_ld(&bar[XB_TMO])) break; if (sp > XB_SPIN_CAP) { atomicAdd(&bar[XB_TMO], 1u); break; } }
    }
    nloc = mine > 0u ? mine : 1u; nx = cnt > 0u ? cnt : 1u;
}
__device__ __forceinline__ void xcd_barrier(const XcdBarrier& b) {
    asm volatile("s_waitcnt vmcnt(0)" ::: "memory");
    __syncthreads();
    if (threadIdx.x == 0) {
        unsigned* bar = b.bar;
        __builtin_amdgcn_s_waitcnt(0);
        unsigned nloc = b.st[0], nx = b.st[1];
        if (nloc == 0u) { xcd_barrier_complete(bar, b.x, nloc, nx); b.st[0] = nloc; b.st[1] = nx; }
        const unsigned old = xb_add(&bar[XB_XSUB(b.x)], 1u);
        const unsigned gen = old / nloc;
        if (old + 1u == (gen + 1u) * nloc) {
            __builtin_amdgcn_fence(__ATOMIC_RELEASE, "agent");
            asm volatile("s_waitcnt vmcnt(0)" ::: "memory");
            const unsigned og = xb_add(&bar[XB_TOP], 1u);
            const unsigned tg = og / nx;
            if (og + 1u == (tg + 1u) * nx) xb_add(&bar[XB_TOPGEN], 1u);
            else XB_SPIN(xb_ld(&bar[XB_TOPGEN]) == tg, bar);
            __builtin_amdgcn_fence(__ATOMIC_ACQUIRE, "agent");
            xb_add(&bar[XB_XGEN(b.x)], 1u);
            asm volatile("s_waitcnt vmcnt(0)" ::: "memory");
        } else {
            XB_SPIN(xb_ld(&bar[XB_XGEN(b.x)]) == gen, bar);
            __builtin_amdgcn_fence(__ATOMIC_ACQUIRE, "agent");
            asm volatile("s_waitcnt vmcnt(0)" ::: "memory");
        }
    }
    __syncthreads();
}

__global__ void __launch_bounds__(512) fwd_mega(Params p) {
    extern __shared__ __attribute__((aligned(16))) unsigned char ldsg[];
    LAS unsigned char* lds = (LAS unsigned char*)ldsg;
    cg::grid_group grid = cg::this_grid();
    volatile LAS unsigned* stw = (volatile LAS unsigned*)(lds + 131072);
    XcdBarrier xbar; xbar.bar = (unsigned*)(p.ws + WS_BAR); xbar.x = 0; xbar.st = stw;
    if (p.coop) { if (threadIdx.x == 0) { stw[0] = 0u; stw[1] = 0u; } __syncthreads(); xbar = xcd_barrier_post((unsigned*)(p.ws + WS_BAR), stw); }
    int nsync = 0;
    for (int ph = p.ph_lo; ph < p.ph_hi; ++ph) {
        run_phase(ph, ldsg, lds);
        if (p.coop && ph + 1 < p.ph_hi) { if (nsync == 0) grid.sync(); else xcd_barrier(xbar); ++nsync; }
    }
}

#ifndef N_LAUNCH_MODE
#define N_LAUNCH_MODE 1
#endif
extern "C" void kernel_launch(void* const* d_in, const int* in_sizes, int n_in, void* d_out, int out_size, void* d_ws, size_t ws_size, hipStream_t stream) {
    static int grid = 0;
    if (grid == 0) {
        int dev = 0, cus = 0, per_cu = 0;
        hipGetDevice(&dev); hipDeviceGetAttribute(&cus, hipDeviceAttributeMultiprocessorCount, dev);
        hipFuncSetAttribute((const void*)fwd_mega, hipFuncAttributeMaxDynamicSharedMemorySize, LDS_BYTES);
        hipOccupancyMaxActiveBlocksPerMultiprocessor(&per_cu, (const void*)fwd_mega, 512, LDS_BYTES);
        (void)hipGetLastError();
        if (per_cu < 1) per_cu = 1;
        grid = cus * 1;
        if (ws_size < WS_END) fprintf(stderr, "kernel_launch: workspace too small: %zu < %zu\n", ws_size, (size_t)WS_END);
    }
    Params p{};
    for (int i = 0; i < 19; ++i) p.in[i] = (const float*)d_in[i];
    p.out = (float*)d_out; p.ws = (unsigned char*)d_ws;
#if N_LAUNCH_MODE == 1
    p.ph_lo = 0; p.ph_hi = NPHASE; p.coop = 1;
    (void)hipMemsetAsync((unsigned char*)d_ws + WS_BAR, 0, XCD_BAR_BYTES, stream);
    void* args[] = {&p};
    hipError_t e = hipLaunchCooperativeKernel((const void*)fwd_mega, dim3(grid), dim3(512), args, LDS_BYTES, stream);
    if (e != hipSuccess) fprintf(stderr, "cooperative launch failed: %s (grid %d)\n", hipGetErrorString(e), grid);
#else
    for (int ph = 0; ph < NPHASE; ++ph) { p.ph_lo = ph; p.ph_hi = ph + 1; p.coop = 0;
        hipLaunchKernelGGL(fwd_mega, dim3(grid), dim3(512), LDS_BYTES, stream, p); }
#endif
}
```

```cpp
#include <hip/hip_runtime.h>
#include <hip/hip_cooperative_groups.h>
#include <cstdio>
namespace cg = cooperative_groups;
namespace pg8 {
#define PG8_LAS __attribute__((address_space(3)))
typedef unsigned short bf16_t;
typedef short bf16x8 __attribute__((ext_vector_type(8)));
typedef float f32x4 __attribute__((ext_vector_type(4)));
typedef unsigned u32x4 __attribute__((ext_vector_type(4)));
constexpr int BM = 256, BK = 64, HALF = 128, HTB = HALF * BK * 2  , STAGE_BYTES = 8 * HTB, NXCD = 8, WGM = 8;

__host__ __device__ __forceinline__ int lds_byte(int r, int c) { const int st = (r >> 4) * 2 + (c >> 5), rr = r & 15, cc = c & 31, ob = rr * 64 + cc * 2; return st * 1024 + (ob ^ (((ob >> 9) & 1) << 5)); }
__host__ __device__ __forceinline__ void stage_rc(int b, int& R, int& C) { const int st = b / 1024, sb = b % 1024, swz = sb ^ (((sb >> 9) & 1) << 5); R = (st >> 1) * 16 + swz / 64; C = (st & 1) * 32 + (swz % 64) / 2; }
__host__ __device__ __forceinline__ int perm32(int rho) { const int n = rho >> 4, i = rho & 15; return 8 * (i >> 2) + 4 * n + (i & 3); }

struct Unit { int pm, pn; };
struct Gemm { const bf16_t* A; const bf16_t* Bt; int M, N, K; };

struct StaticOrder {
    int nM, nN, nwg, G, c;
    __host__ __device__ void init(int M, int N, int G_, int c_) { nM = M / BM; nN = N / BM; nwg = nM * nN; G = G_; c = c_; }
    __host__ __device__ bool next(int i, Unit& u) const {
        const long L = (long)i * G + c; if (L >= nwg) return false;
        int wgid = (int)L; { const int q = nwg / NXCD, r = nwg % NXCD, xcd = wgid % NXCD, off = wgid / NXCD; wgid = (xcd < r ? xcd * (q + 1) : r * (q + 1) + (xcd - r) * q) + off; }
        const int nig = WGM * nN, gid = wgid / nig, fm = gid * WGM, gsz = (nM - fm) < WGM ? (nM - fm) : WGM;
        u.pm = fm + ((wgid % nig) % gsz); u.pn = (wgid % nig) / gsz; return true;
    }
    __device__ __forceinline__ void a_ready(const Unit&) const {}
    __device__ __forceinline__ void done(const Unit&) const {}
};
typedef float cvt_f32x2 __attribute__((ext_vector_type(2)));
typedef __bf16 cvt_bf16x2 __attribute__((ext_vector_type(2)));
__device__ __forceinline__ unsigned cvt_pk_bf16(float lo, float hi) { const cvt_f32x2 v = {lo, hi}; const cvt_bf16x2 b = __builtin_convertvector(v, cvt_bf16x2); return __builtin_bit_cast(unsigned, b); }
template <class Epi, class Sched, bool STAMP = false>
__device__ __forceinline__ void gemm_phase(PG8_LAS unsigned char* lds, const Gemm g, const Sched& S, const Epi& E, unsigned long long* stamps) {
    int tid = threadIdx.x; asm volatile("" : "+v"(tid)); const int wid = __builtin_amdgcn_readfirstlane(tid >> 6), lane = tid & 63, wr = wid >> 2, wc = wid & 3, fr = lane & 15, fq = lane >> 4;
    const int K = g.K, nt = K / BK;
    int ts_lo = 0, ts_hi = 0, nts = 0; const unsigned long long rt_entry = STAMP ? (unsigned long long)wall_clock64() : 0ull;
#define PG8_STAMP() do { if (STAMP && wid == 0 && nts < 64) { const unsigned long long _c = (unsigned long long)clock64(); \
        ts_lo = (lane == nts) ? (int)(unsigned)_c : ts_lo; ts_hi = (lane == nts) ? (int)(unsigned)(_c >> 32) : ts_hi; ++nts; } } while (0)
    PG8_STAMP();
    unsigned voffA[2], voffB[2];
#pragma unroll
    for (int i = 0; i < 2; ++i) { int R, C; stage_rc(tid * 16 + i * 8192, R, C); const int Rb = Epi::PERM ? ((R & ~31) + perm32(R & 31)) : R;
        voffA[i] = (unsigned)(R * K + C) * 2u; voffB[i] = (unsigned)(Rb * K + C) * 2u; }
    const size_t kstep = (size_t)(BK * 2);
    const size_t hstep = (size_t)HALF * K * 2;
    const size_t tstep = 2 * hstep;
    const unsigned ldsw = (unsigned)wid * 1024u;
    const int aoff = lds_byte(wr * 64 + fr, fq * 8), boff = lds_byte(wc * 32 + fr, fq * 8);
#define PG8_SA(b, h) (((b) * 2 + (h)) * HTB)
#define PG8_SB(b, h) ((4 + (b) * 2 + (h)) * HTB)
#define PG8_STAGE(bufoff, gbase, voff) do { _Pragma("unroll") for (int _i = 0; _i < 2; ++_i) \
        __builtin_amdgcn_global_load_lds((const unsigned*)((const char*)(gbase) + (voff)[_i]), (PG8_LAS unsigned*)(lds + (bufoff) + ldsw + _i * 8192), 16, 0, 0); } while (0)
#define PG8_LDA(dst, b, h) do { _Pragma("unroll") for (int m = 0; m < 4; ++m) _Pragma("unroll") for (int k = 0; k < 2; ++k) dst[m][k] = *(const PG8_LAS bf16x8*)(lds + PG8_SA(b, h) + aoff + m * 2048 + k * 1024); } while (0)
#define PG8_LDB(dst, b, h) do { _Pragma("unroll") for (int n = 0; n < 2; ++n) _Pragma("unroll") for (int k = 0; k < 2; ++k) dst[n][k] = *(const PG8_LAS bf16x8*)(lds + PG8_SB(b, h) + boff + n * 2048 + k * 1024); } while (0)
#define PG8_MMA(ai, bj, At, Bt) do { __builtin_amdgcn_s_setprio(1); _Pragma("unroll") for (int m = 0; m < 4; ++m) _Pragma("unroll") for (int n = 0; n < 2; ++n) _Pragma("unroll") for (int k = 0; k < 2; ++k) \
        acc[ai][bj][m][n] = __builtin_amdgcn_mfma_f32_16x16x32_bf16(Bt[n][k], At[m][k], acc[ai][bj][m][n], 0, 0, 0); __builtin_amdgcn_s_setprio(0); } while (0)
#define PG8_WAIT_V(n) asm volatile("s_waitcnt vmcnt(" #n ")" ::: "memory")
#define PG8_WAIT_L(n) asm volatile("s_waitcnt lgkmcnt(" #n ")" ::: "memory")
#define PG8_BAR __builtin_amdgcn_s_barrier()
#define PG8_SCHED __builtin_amdgcn_sched_barrier(0)
    Unit cur, nxt; int ui = 0;
    if (!S.next(0, cur)) return;
    f32x4 acc[2][2][4][2];
#pragma unroll
    for (int a = 0; a < 2; ++a)
#pragma unroll
        for (int b = 0; b < 2; ++b)
#pragma unroll
            for (int m = 0; m < 4; ++m)
#pragma unroll
                for (int n = 0; n < 2; ++n) acc[a][b][m][n] = (f32x4){0.f, 0.f, 0.f, 0.f};
    bf16x8 At[4][2], B0[2][2], B1[2][2];
    const char* cA = (const char*)g.A + (size_t)cur.pm * tstep; const char* cB = (const char*)g.Bt + (size_t)cur.pn * tstep;
    S.a_ready(cur);
    PG8_STAGE(PG8_SB(0, 0), cB, voffB); PG8_STAGE(PG8_SA(0, 0), cA, voffA); PG8_STAGE(PG8_SB(0, 1), cB + hstep, voffB); PG8_STAGE(PG8_SA(0, 1), cA + hstep, voffA);
    if (wr == 1) PG8_BAR;
    PG8_WAIT_V(4); PG8_BAR;
    PG8_STAGE(PG8_SB(1, 0), cB + kstep, voffB); PG8_STAGE(PG8_SA(1, 0), cA + kstep, voffA); PG8_STAGE(PG8_SB(1, 1), cB + hstep + kstep, voffB);
    PG8_WAIT_V(6); PG8_BAR;
    PG8_STAMP();
    for (;;) {
        const bool has_next = S.next(ui + 1, nxt);
        const char* nA = has_next ? (const char*)g.A + (size_t)nxt.pm * tstep : cA; const char* nB = has_next ? (const char*)g.Bt + (size_t)nxt.pn * tstep : cB;
        for (int t = 0; t < nt; t += 2) {
            const bool last = (t == nt - 2);
            const char* a1 = cA + (size_t)(t + 1) * kstep;
            const char* a2 = last ? nA : cA + (size_t)(t + 2) * kstep; const char* b2 = last ? nB : cB + (size_t)(t + 2) * kstep;
            const char* a3 = a2 + kstep; const char* b3 = b2 + kstep;
            if (last && has_next) S.a_ready(nxt);
            PG8_LDB(B0, 0, 0); PG8_SCHED; PG8_LDA(At, 0, 0); PG8_STAGE(PG8_SA(1, 1), a1 + hstep, voffA);
            PG8_WAIT_L(8); PG8_BAR; PG8_WAIT_L(0); PG8_MMA(0, 0, At, B0); PG8_BAR; PG8_SCHED;
            PG8_LDB(B1, 0, 1); PG8_STAGE(PG8_SB(0, 0), b2, voffB);
            PG8_BAR; PG8_WAIT_L(0); PG8_MMA(0, 1, At, B1); PG8_BAR;
            PG8_LDA(At, 0, 1); PG8_STAGE(PG8_SA(0, 0), a2, voffA);
            PG8_BAR; PG8_WAIT_L(0); PG8_MMA(1, 0, At, B0); PG8_BAR; PG8_SCHED;
            PG8_STAGE(PG8_SB(0, 1), b2 + hstep, voffB);
            PG8_WAIT_V(6); PG8_BAR; PG8_MMA(1, 1, At, B1); PG8_BAR;
            PG8_LDB(B0, 1, 0); PG8_SCHED; PG8_LDA(At, 1, 0); PG8_STAGE(PG8_SA(0, 1), a2 + hstep, voffA);
            PG8_WAIT_L(8); PG8_BAR; PG8_WAIT_L(0); PG8_MMA(0, 0, At, B0); PG8_BAR; PG8_SCHED;
            PG8_LDB(B1, 1, 1); PG8_STAGE(PG8_SB(1, 0), b3, voffB);
            PG8_BAR; PG8_WAIT_L(0); PG8_MMA(0, 1, At, B1); PG8_BAR;
            PG8_LDA(At, 1, 1); PG8_STAGE(PG8_SA(1, 0), a3, voffA);
            PG8_BAR; PG8_WAIT_L(0); PG8_MMA(1, 0, At, B0); PG8_BAR; PG8_SCHED;
            PG8_STAGE(PG8_SB(1, 1), b3 + hstep, voffB);
            PG8_WAIT_V(6); PG8_BAR; PG8_MMA(1, 1, At, B1); PG8_BAR;
        }
        PG8_STAMP();
        if constexpr (!Epi::AFTER_DRAIN) { E(acc, cur, wr, wc, fr, fq); S.done(cur); }
        PG8_STAMP();
        if (!has_next) break;
#pragma unroll
        for (int a = 0; a < 2; ++a)
#pragma unroll
            for (int b = 0; b < 2; ++b)
#pragma unroll
                for (int m = 0; m < 4; ++m)
#pragma unroll
                    for (int n = 0; n < 2; ++n) acc[a][b][m][n] = (f32x4){0.f, 0.f, 0.f, 0.f};
        cur = nxt; cA = nA; cB = nB; ++ui;
    }
    PG8_WAIT_V(0);
    if (wr == 0) PG8_BAR;
    PG8_BAR;
    if constexpr (Epi::AFTER_DRAIN) { E.fused(acc, cur, wr, wc, fr, fq, lds, wid, lane); S.done(cur); }
    PG8_STAMP();
    if (STAMP && wid == 0) { stamps[lane] = lane < nts ? (((unsigned long long)(unsigned)ts_hi << 32) | (unsigned)ts_lo) : 0ull;
        if (lane == 62) stamps[62] = rt_entry; if (lane == 63) stamps[63] = (unsigned long long)wall_clock64(); }
#undef PG8_STAMP
#undef PG8_SA
#undef PG8_SB
#undef PG8_STAGE
#undef PG8_LDA
#undef PG8_LDB
#undef PG8_MMA
#undef PG8_WAIT_V
#undef PG8_WAIT_L
#undef PG8_BAR
#undef PG8_SCHED
}
}

using pg8::bf16_t; using pg8::bf16x8; using pg8::f32x4; using pg8::u32x4;
typedef unsigned u32x2 __attribute__((ext_vector_type(2)));
#define LAS __attribute__((address_space(3)))

constexpr int SEQ = 4096, MTOK = 32768, NL = 4;
constexpr float ALPHA = 1.681792830507429f;
constexpr int LDS_BYTES = 131072 + 16;
constexpr int NPHASE = 1 + 9 * NL;
constexpr int XCD_BAR_BYTES = 3456 * 4;

constexpr size_t WS_WIN = 0;
constexpr size_t WS_WOUT = WS_WIN + (size_t)NL * 3072 * 1024 * 2;
constexpr size_t WS_WGU = WS_WOUT + (size_t)NL * 1024 * 1024 * 2;
constexpr size_t WS_WD = WS_WGU + (size_t)NL * 5632 * 1024 * 2;
constexpr size_t WS_LRUW = WS_WD + (size_t)NL * 1024 * 2816 * 2;
constexpr size_t WS_ROPE = WS_LRUW + (size_t)NL * 2 * 2 * 6 * 4096 * 2;
constexpr size_t WS_XB = WS_ROPE + (size_t)4096 * 32 * 8;
constexpr size_t WS_R1 = WS_XB + (size_t)MTOK * 1024 * 2;
constexpr size_t WS_R2 = WS_R1 + (size_t)MTOK * 3072 * 2;
constexpr size_t WS_Y = WS_R2;
constexpr size_t WS_KV = WS_Y + (size_t)MTOK * 1024 * 2;
constexpr size_t WS_ST = WS_KV + (size_t)1536 * 2 * 4096 * 4;
constexpr size_t WS_R2END = WS_ST + (size_t)1536 * 2 * 4096 * 2;
constexpr size_t WS_AGG = WS_R2END;
constexpr size_t WS_CARRY = WS_AGG + (size_t)8 * 128 * 2 * 384 * 8;
constexpr size_t WS_BAR = WS_CARRY + (size_t)8 * 128 * 2 * 384 * 4;
constexpr size_t WS_LRUC = WS_BAR + (size_t)XCD_BAR_BYTES + 4096;
constexpr size_t WS_END = WS_LRUC + (size_t)NL * 2 * 384 * 16;

__device__ __forceinline__ int tidx() { int t = threadIdx.x; asm volatile("" : "+v"(t)); return t; }
__device__ __forceinline__ int bidx() { int b = blockIdx.x; asm volatile("" : "+s"(b)); return b; }
struct Params { const float* in[19]; float* out; unsigned char* ws; int ph_lo, ph_hi, coop, pad; };

__device__ __forceinline__ float bflo(unsigned w) { return __uint_as_float(w << 16); }
__device__ __forceinline__ float bfhi(unsigned w) { return __uint_as_float(w & 0xffff0000u); }
#define BFEL(v, jj) (((jj) & 1) ? bfhi((v)[(jj) >> 1]) : bflo((v)[(jj) >> 1]))
__device__ __forceinline__ unsigned pk(float lo, float hi) { return pg8::cvt_pk_bf16(lo, hi); }
__device__ __forceinline__ unsigned short f2bf(float f) { return (unsigned short)(pk(f, 0.f) & 0xffffu); }
__device__ __forceinline__ bf16x8 as_frag(u32x4 v) { return __builtin_bit_cast(bf16x8, v); }
__device__ __forceinline__ f32x4 mfma16(bf16x8 a, bf16x8 b, f32x4 c) { return __builtin_amdgcn_mfma_f32_16x16x32_bf16(a, b, c, 0, 0, 0); }
__device__ __forceinline__ float sigm(float x) { return __builtin_amdgcn_rcpf(1.0f + __builtin_amdgcn_exp2f(x * -1.4426950408889634f)); }
__device__ __forceinline__ float log2gamma(int h) {
    return h == 0 ? -0.04580368961312479f : h == 1 ? -0.02272007650008353f : h == 2 ? -0.011315313227834146f
         : h == 3 ? -0.005646563141142063f : h == 4 ? -0.0028205190623786626f : -0.0014095702546713536f;
}
__device__ __forceinline__ int clampi(int v, int lo, int hi) { return v < lo ? lo : (v > hi ? hi : v); }

struct EpiProj {
    static constexpr bool PERM = true, AFTER_DRAIN = false;
    bf16_t* O; int ldc;
    __device__ __forceinline__ void operator()(const f32x4 (&acc)[2][2][4][2], const pg8::Unit& u, int wr, int wc, int fr, int fq) const {
        const int row0 = u.pm * 256 + wr * 64 + fr, col0 = u.pn * 256 + wc * 32 + 8 * fq;
#pragma unroll
        for (int ai = 0; ai < 2; ++ai)
#pragma unroll
            for (int m = 0; m < 4; ++m) { bf16_t* rowp = O + (size_t)(row0 + ai * 128 + m * 16) * ldc + col0;
#pragma unroll
                for (int bj = 0; bj < 2; ++bj) { const f32x4 v0 = acc[ai][bj][m][0], v1 = acc[ai][bj][m][1];
                    u32x4 w; w.x = pk(v0[0], v0[1]); w.y = pk(v0[2], v0[3]); w.z = pk(v1[0], v1[1]); w.w = pk(v1[2], v1[3]);
                    *(u32x4*)(rowp + bj * 128) = w; } asm volatile("" ::: "memory"); }
    }
};
struct EpiSwiglu {
    static constexpr bool PERM = false, AFTER_DRAIN = false;
    bf16_t* H;
    __device__ __forceinline__ void operator()(const f32x4 (&acc)[2][2][4][2], const pg8::Unit& u, int wr, int wc, int fr, int fq) const {
        const int row0 = u.pm * 256 + wr * 64 + fr, h0 = u.pn * 128 + wc * 32 + 8 * fq;
#pragma unroll
        for (int ai = 0; ai < 2; ++ai)
#pragma unroll
            for (int m = 0; m < 4; ++m) { bf16_t* rowp = H + (size_t)(row0 + ai * 128 + m * 16) * 2816 + h0; float hv[8];
#pragma unroll
                for (int bj = 0; bj < 2; ++bj) { const f32x4 g = acc[ai][bj][m][0], uu = acc[ai][bj][m][1];
#pragma unroll
                    for (int e = 0; e < 4; ++e) hv[bj * 4 + e] = g[e] * sigm(g[e]) * uu[e]; }
                u32x4 w; w.x = pk(hv[0], hv[1]); w.y = pk(hv[2], hv[3]); w.z = pk(hv[4], hv[5]); w.w = pk(hv[6], hv[7]);
                *(u32x4*)rowp = w; asm volatile("" ::: "memory"); }
    }
};

__device__ void phase_init(const Params& p, unsigned char* ldsg) {
    const int tid = tidx(), nb = gridDim.x, bid = bidx();
    float* tile = (float*)ldsg;
    unsigned char* ws = p.ws;
    for (int T = bid; T < NL * 3136; T += nb) {
        const int l = T / 3136; int r = T % 3136;
        const float* src; int ldsrc, lddst, k0, n0, mode = 0; bf16_t* dst;
        if (r >= 2368) { r -= 2368; src = p.in[1] + (size_t)l * 1024 * 3072; ldsrc = 3072; dst = (bf16_t*)(ws + WS_WIN) + (size_t)l * 3072 * 1024; lddst = 1024; k0 = (r / 48) * 64; n0 = (r % 48) * 64; }
        else if (r < 256) { src = p.in[11] + (size_t)l * 1024 * 1024; ldsrc = 1024; dst = (bf16_t*)(ws + WS_WOUT) + (size_t)l * 1024 * 1024; lddst = 1024; k0 = (r / 16) * 64; n0 = (r % 16) * 64; }
        else if (r < 960) { r -= 256; src = p.in[14] + (size_t)l * 1024 * 2816; ldsrc = 2816; dst = (bf16_t*)(ws + WS_WGU) + (size_t)l * 5632 * 1024; lddst = 1024; k0 = (r / 44) * 64; n0 = (r % 44) * 64; mode = 1; }
        else if (r < 1664) { r -= 960; src = p.in[15] + (size_t)l * 1024 * 2816; ldsrc = 2816; dst = (bf16_t*)(ws + WS_WGU) + (size_t)l * 5632 * 1024; lddst = 1024; k0 = (r / 44) * 64; n0 = (r % 44) * 64; mode = 2; }
        else { r -= 1664; src = p.in[16] + (size_t)l * 2816 * 1024; ldsrc = 1024; dst = (bf16_t*)(ws + WS_WD) + (size_t)l * 1024 * 2816; lddst = 2816; k0 = (r / 16) * 64; n0 = (r % 16) * 64; }
#pragma unroll
        for (int i = 0; i < 2; ++i) { const int k = (tid >> 4) + 32 * i, n4 = (tid & 15) * 4;
            const float4 v = *(const float4*)(src + (size_t)(k0 + k) * ldsrc + n0 + n4);
            tile[k * 65 + n4 + 0] = v.x; tile[k * 65 + n4 + 1] = v.y; tile[k * 65 + n4 + 2] = v.z; tile[k * 65 + n4 + 3] = v.w; }
        __syncthreads();
        { const int n = tid >> 3, k8 = (tid & 7) * 8; float f[8];
#pragma unroll
            for (int j = 0; j < 8; ++j) f[j] = tile[(k8 + j) * 65 + n];
            const int ng = n0 + n; int drow = ng;
            if (mode) { const int hh = ng & 127; drow = (ng >> 7) * 256 + 128 * ((hh >> 2) & 1) + 32 * (hh >> 5) + 16 * (mode - 1) + 4 * ((hh >> 3) & 3) + (hh & 3); }
            u32x4 w; w.x = pk(f[0], f[1]); w.y = pk(f[2], f[3]); w.z = pk(f[4], f[5]); w.w = pk(f[6], f[7]);
            *(u32x4*)(dst + (size_t)drow * lddst + k0 + k8) = w; }
        __syncthreads();
    }
    const int gt = bid * 512 + tid, gn = nb * 512;
    { const float* x = p.in[0]; bf16_t* xb = (bf16_t*)(ws + WS_XB);
      for (int i = gt; i < MTOK * 1024 / 8; i += gn) { const float4 a = *(const float4*)(x + (size_t)i * 8), b = *(const float4*)(x + (size_t)i * 8 + 4);
          u32x4 w; w.x = pk(a.x, a.y); w.y = pk(a.z, a.w); w.z = pk(b.x, b.y); w.w = pk(b.z, b.w); *(u32x4*)(xb + (size_t)i * 8) = w; } }
    { float2* rope = (float2*)(ws + WS_ROPE);
      for (int idx = gt; idx < 4096 * 32; idx += gn) { const int pos = idx >> 5, i = idx & 31;
          double f = 1.0; for (int k = 0; k < i; ++k) f *= 0.7498942093324559;
          const float inv = (float)f; const float ang = (float)pos * inv;
          const double a = (double)ang; const double nrev = rint(a * 0.15915494309189535); const double rr = (a - nrev * 6.283185307179586) * 0.25;
          const double r2 = rr * rr;
          double s = rr * (1.0 + r2 * (-1.0 / 6 + r2 * (1.0 / 120 + r2 * (-1.0 / 5040 + r2 * (1.0 / 362880 + r2 * (-1.0 / 39916800))))));
          double c = 1.0 + r2 * (-0.5 + r2 * (1.0 / 24 + r2 * (-1.0 / 720 + r2 * (1.0 / 40320 + r2 * (-1.0 / 3628800 + r2 * (1.0 / 479001600))))));
          double s2 = 2 * s * c, c2 = c * c - s * s; s = 2 * s2 * c2; c = c2 * c2 - s2 * s2;
          rope[idx] = make_float2((float)c, (float)s); } }
    { float4* lc = (float4*)(ws + WS_LRUC);
      for (int idx = gt; idx < NL * 2 * 384; idx += gn) { const float ba = p.in[5][idx], bx = p.in[7][idx], lam = p.in[8][idx];
          const float nl = -lam; const float sp = fmaxf(nl, 0.f) + log1pf(expf(-fabsf(nl)));
          lc[idx] = make_float4(-8.0f * sp * 1.4426950408889634f, -1.4426950408889634f * ba, -1.4426950408889634f * bx, 0.f); } }
    { bf16_t* wt = (bf16_t*)(ws + WS_LRUW);
      for (int idx = gt; idx < NL * 2 * 2 * 6 * 64 * 8; idx += gn) { const int c8 = idx & 7, o = (idx >> 3) & 63, mat = idx >> 9;
          const int g = mat % 6, kind = (mat / 6) & 1, dir = (mat / 12) & 1, l = mat / 24;
          const float* src = (kind ? p.in[6] : p.in[4]) + ((size_t)((l * 2 + dir) * 6 + g) * 64 + c8 * 8) * 64 + o; float f[8];
#pragma unroll
          for (int j = 0; j < 8; ++j) f[j] = src[j * 64];
          u32x4 w; w.x = pk(f[0], f[1]); w.y = pk(f[2], f[3]); w.z = pk(f[4], f[5]); w.w = pk(f[6], f[7]);
          *(u32x4*)(wt + (size_t)mat * 4096 + o * 64 + c8 * 8) = w; } }
}

__device__ void phase_ln(const float* xin, const bf16_t* br, const float* g, const float* bta, float* xo, bf16_t* xb) {
    const int tid = tidx(), lane = tid & 63, wid = tid >> 6;
    float4 gg[4], bb[4];
#pragma unroll
    for (int i = 0; i < 4; ++i) { gg[i] = ((const float4*)g)[lane + 64 * i]; bb[i] = ((const float4*)bta)[lane + 64 * i]; }
    const int rstep = gridDim.x * 8;
    int row = bidx() * 8 + wid;
    float4 nx[4]; u32x2 nb_[4];
    if (row < MTOK) {
#pragma unroll
        for (int i = 0; i < 4; ++i) { nx[i] = ((const float4*)(xin + (size_t)row * 1024))[lane + 64 * i]; nb_[i] = ((const u32x2*)(br + (size_t)row * 1024))[lane + 64 * i]; } }
    for (; row < MTOK; row += rstep) {
        float4 a[4]; float s = 0.f;
#pragma unroll
        for (int i = 0; i < 4; ++i) { const float4 x4 = nx[i]; const u32x2 b2 = nb_[i];
            a[i].x = x4.x * ALPHA + bflo(b2.x); a[i].y = x4.y * ALPHA + bfhi(b2.x); a[i].z = x4.z * ALPHA + bflo(b2.y); a[i].w = x4.w * ALPHA + bfhi(b2.y);
            s += (a[i].x + a[i].y) + (a[i].z + a[i].w); }
        const int rn = row + rstep;
        if (rn < MTOK) {
#pragma unroll
            for (int i = 0; i < 4; ++i) { nx[i] = ((const float4*)(xin + (size_t)rn * 1024))[lane + 64 * i]; nb_[i] = ((const u32x2*)(br + (size_t)rn * 1024))[lane + 64 * i]; } }
#pragma unroll
        for (int o = 32; o >= 1; o >>= 1) s += __shfl_xor(s, o);
        const float mu = s * (1.0f / 1024.0f); float q = 0.f;
#pragma unroll
        for (int i = 0; i < 4; ++i) { a[i].x -= mu; a[i].y -= mu; a[i].z -= mu; a[i].w -= mu; q += (a[i].x * a[i].x + a[i].y * a[i].y) + (a[i].z * a[i].z + a[i].w * a[i].w); }
#pragma unroll
        for (int o = 32; o >= 1; o >>= 1) q += __shfl_xor(q, o);
        const float rstd = rsqrtf(q * (1.0f / 1024.0f) + 1e-5f);
#pragma unroll
        for (int i = 0; i < 4; ++i) { float4 y; y.x = a[i].x * rstd * gg[i].x + bb[i].x; y.y = a[i].y * rstd * gg[i].y + bb[i].y; y.z = a[i].z * rstd * gg[i].z + bb[i].z; y.w = a[i].w * rstd * gg[i].w + bb[i].w;
            ((float4*)(xo + (size_t)row * 1024))[lane + 64 * i] = y;
            if (xb) { u32x2 w; w.x = pk(y.x, y.y); w.y = pk(y.z, y.w); *(u32x2*)(xb + (size_t)row * 1024 + (lane + 64 * i) * 4) = w; } }
    }
}

typedef short v4i16_t __attribute__((ext_vector_type(4)));
constexpr int NSTR = 72;
constexpr float LOG2E = 1.4426950408889634f;
__device__ __forceinline__ bf16x8 tr8(const bf16_t* p0) {
    const v4i16_t a = __builtin_amdgcn_ds_read_tr16_b64_v4i16((LAS v4i16_t*)p0);
    const v4i16_t b = __builtin_amdgcn_ds_read_tr16_b64_v4i16((LAS v4i16_t*)(p0 + 4 * NSTR));
    return __builtin_shufflevector(a, b, 0, 1, 2, 3, 4, 5, 6, 7);
}

struct NatRegs { u32x4 v[9]; };
__device__ __forceinline__ void nat_geom(int item, int& b, int& h, int& r0, int& rs0, int& rs1, int& nrows) {
    const int rp = item & 31; h = (item >> 5) & 3; b = item >> 7; r0 = 2 * rp; rs0 = clampi(r0 - 4, 0, 56); rs1 = clampi(r0 - 3, 0, 56); nrows = rs1 + 8 - rs0;
}
__device__ __forceinline__ void nat_load(NatRegs& R, const bf16_t* proj, int item, int tid) {
    int b, h, r0, rs0, rs1, nrows; nat_geom(item, b, h, r0, rs0, rs1, nrows);
    const bf16_t* vbase = proj + ((size_t)b * 4096 + rs0 * 64) * 3072 + 2816 + h * 64;
#pragma unroll
    for (int i = 0; i < 9; ++i) { const int idx = tid + 512 * i, key = idx >> 3, ds = idx & 7;
        if (i < 8 || nrows == 9) R.v[i] = *(const u32x4*)(vbase + (size_t)key * 3072 + ds * 8); }
}
__device__ __forceinline__ void nat_store(const NatRegs& R, bf16_t* V, int item, int tid) {
    int b, h, r0, rs0, rs1, nrows; nat_geom(item, b, h, r0, rs0, rs1, nrows);
#pragma unroll
    for (int i = 0; i < 9; ++i) { const int idx = tid + 512 * i, key = idx >> 3, ds = idx & 7;
        if (i < 8 || nrows == 9) *(u32x4*)(V + key * NSTR + ds * 8) = R.v[i]; }
}
__device__ __forceinline__ void nat_compute(const bf16_t* proj, bf16_t* y, const bf16_t* V, const float* rpball, int item, int tid) {
    const int wid = tid >> 6, lane = tid & 63, fr = lane & 15, fq = lane >> 4;
    int b, h, r0, rs0, rs1, nrows; nat_geom(item, b, h, r0, rs0, rs1, nrows);
    const float* rpb = rpball + h * 465; const int rbase = rs0;
    const int rsel = wid >> 2, n = wid & 3, r = r0 + rsel, rs = rsel ? rs1 : rs0, c0 = n * 16, ss = clampi(c0 - 8, 0, 32);
    const bf16_t* qp = proj + ((size_t)b * 4096 + r * 64 + c0 + fr) * 3072 + 2304 + h * 64 + fq * 8;
    const bf16x8 q0 = *(const bf16x8*)qp, q1 = *(const bf16x8*)(qp + 32);
    f32x4 s[8][2];
#pragma unroll
    for (int kr = 0; kr < 8; ++kr)
#pragma unroll
        for (int t = 0; t < 2; ++t) { const int kcol = ss + (fr >> 2) * 8 + 4 * t + (fr & 3);
            const bf16_t* kp = proj + ((size_t)b * 4096 + (rs + kr) * 64 + kcol) * 3072 + 2560 + h * 64 + fq * 8;
            const bf16x8 k0 = *(const bf16x8*)kp, k1 = *(const bf16x8*)(kp + 32);
            f32x4 a = {0.f, 0.f, 0.f, 0.f}; a = mfma16(k0, q0, a); a = mfma16(k1, q1, a); s[kr][t] = a;
            if (kr == 3 && t == 1) asm volatile("" ::: "memory"); }
    const int qc = c0 + fr, cst = clampi(qc - 8, 0, 48);
    float mx = -3.0e38f;
#pragma unroll
    for (int kr = 0; kr < 8; ++kr) { const int ri = rs + kr - r + 7;
#pragma unroll
        for (int t = 0; t < 2; ++t)
#pragma unroll
            for (int e = 0; e < 4; ++e) { const int kc = ss + fq * 8 + 4 * t + e; const bool valid = (kc >= cst) && (kc < cst + 16);
                const int ci = clampi(kc - qc, -15, 15) + 15;
                const float v = valid ? s[kr][t][e] * 0.125f + rpb[ri * 31 + ci] : -3.0e38f; s[kr][t][e] = v; mx = fmaxf(mx, v); } }
    mx = fmaxf(mx, __shfl_xor(mx, 16)); mx = fmaxf(mx, __shfl_xor(mx, 32));
    float sum = 0.f;
#pragma unroll
    for (int kr = 0; kr < 8; ++kr)
#pragma unroll
        for (int t = 0; t < 2; ++t)
#pragma unroll
            for (int e = 0; e < 4; ++e) { const float v = s[kr][t][e]; const float pe = (v > -1.0e38f) ? __expf(v - mx) : 0.f; s[kr][t][e] = pe; sum += pe; }
    sum += __shfl_xor(sum, 16); sum += __shfl_xor(sum, 32);
    const float inv = 1.0f / sum;
    f32x4 o[4];
#pragma unroll
    for (int dt = 0; dt < 4; ++dt) o[dt] = (f32x4){0.f, 0.f, 0.f, 0.f};
#pragma unroll
    for (int kr = 0; kr < 8; ++kr) { u32x4 pw; pw.x = pk(s[kr][0][0] * inv, s[kr][0][1] * inv); pw.y = pk(s[kr][0][2] * inv, s[kr][0][3] * inv);
        pw.z = pk(s[kr][1][0] * inv, s[kr][1][1] * inv); pw.w = pk(s[kr][1][2] * inv, s[kr][1][3] * inv); const bf16x8 pf = as_frag(pw);
        const bf16_t* vrow = V + ((rs + kr - rbase) * 64 + ss + fq * 8 + (fr >> 2)) * NSTR + (fr & 3) * 4;
#pragma unroll
        for (int dt = 0; dt < 4; ++dt) { const bf16x8 vf = tr8(vrow + dt * 16); o[dt] = mfma16(vf, pf, o[dt]); } }
    bf16_t* yp = y + ((size_t)b * 4096 + r * 64 + c0 + fr) * 1024 + 768 + h * 64 + fq * 4;
#pragma unroll
    for (int dt = 0; dt < 4; ++dt) { u32x2 w; w.x = pk(o[dt][0], o[dt][1]); w.y = pk(o[dt][2], o[dt][3]); *(u32x2*)(yp + dt * 16) = w; }
}

struct RetRegs { u32x4 qlo, qhi, klo, khi, v0, v1; float4 cs[4]; };
template <bool WITHQ>
__device__ __forceinline__ void ret_load(RetRegs& R, const bf16_t* proj, const float2* rope, int item, int tid) {
    const int n = item & 31, h = (item >> 5) % 6, b = item / 192, j = tid >> 2, ds = tid & 3, pos = n * 128 + j; const size_t tok = (size_t)b * 4096 + pos;
    const bf16_t* kp = proj + tok * 3072 + 1152 + h * 64 + ds * 8;
    R.klo = *(const u32x4*)kp; R.khi = *(const u32x4*)(kp + 32);
    if (WITHQ) { R.qlo = *(const u32x4*)(kp - 384); R.qhi = *(const u32x4*)(kp - 384 + 32); }
    const bf16_t* vp = proj + tok * 3072 + 1536 + h * 64 + ds * 16; R.v0 = *(const u32x4*)vp; R.v1 = *(const u32x4*)(vp + 8);
    const float4* cs = (const float4*)(rope + pos * 32 + ds * 8);
#pragma unroll
    for (int i = 0; i < 4; ++i) R.cs[i] = cs[i];
}
__device__ __forceinline__ void rope8(const u32x4& lo, const u32x4& hi, const float4 (&cs)[4], float s1, float s2, u32x4& o1a, u32x4& o2a, u32x4& o1b, u32x4& o2b) {
    float a1[8], a2[8];
#pragma unroll
    for (int jp = 0; jp < 4; ++jp)
#pragma unroll
        for (int hh = 0; hh < 2; ++hh) { const int jj = jp * 2 + hh; const float c = hh ? cs[jp].z : cs[jp].x, sn = hh ? cs[jp].w : cs[jp].y;
            const float t1 = BFEL(lo, jj), t2 = BFEL(hi, jj); a1[jj] = t1 * c - t2 * sn; a2[jj] = t1 * sn + t2 * c; }
    o1a.x = pk(a1[0] * s1, a1[1] * s1); o1a.y = pk(a1[2] * s1, a1[3] * s1); o1a.z = pk(a1[4] * s1, a1[5] * s1); o1a.w = pk(a1[6] * s1, a1[7] * s1);
    o2a.x = pk(a2[0] * s1, a2[1] * s1); o2a.y = pk(a2[2] * s1, a2[3] * s1); o2a.z = pk(a2[4] * s1, a2[5] * s1); o2a.w = pk(a2[6] * s1, a2[7] * s1);
    o1b.x = pk(a1[0] * s2, a1[1] * s2); o1b.y = pk(a1[2] * s2, a1[3] * s2); o1b.z = pk(a1[4] * s2, a1[5] * s2); o1b.w = pk(a1[6] * s2, a1[7] * s2);
    o2b.x = pk(a2[0] * s2, a2[1] * s2); o2b.y = pk(a2[2] * s2, a2[3] * s2); o2b.z = pk(a2[4] * s2, a2[5] * s2); o2b.w = pk(a2[6] * s2, a2[7] * s2);
}
__device__ __forceinline__ void ret_a_store(const RetRegs& R, bf16_t* lds, int item, int tid) {
    const int h = (item >> 5) % 6, j = tid >> 2, ds = tid & 3; const float l2g = log2gamma(h);
    bf16_t* Kf = lds; bf16_t* Kb = Kf + 128 * NSTR; bf16_t* V = Kb + 128 * NSTR;
    const float wf = __builtin_amdgcn_exp2f((float)(127 - j) * l2g) * 0.125f, wb = __builtin_amdgcn_exp2f((float)j * l2g) * 0.125f;
    u32x4 f1, f2, b1, b2; rope8(R.klo, R.khi, R.cs, wf, wb, f1, f2, b1, b2);
    *(u32x4*)(Kf + j * NSTR + ds * 8) = f1; *(u32x4*)(Kf + j * NSTR + 32 + ds * 8) = f2;
    *(u32x4*)(Kb + j * NSTR + ds * 8) = b1; *(u32x4*)(Kb + j * NSTR + 32 + ds * 8) = b2;
    *(u32x4*)(V + j * NSTR + ds * 16) = R.v0; *(u32x4*)(V + j * NSTR + ds * 16 + 8) = R.v1;
}
__device__ __forceinline__ void ret_a_compute(bf16_t* kv, const bf16_t* lds, int item, int tid) {
    const int wid = tid >> 6, lane = tid & 63, fr = lane & 15, fq = lane >> 4;
    const bf16_t* Kf = lds; const bf16_t* Kb = Kf + 128 * NSTR; const bf16_t* V = Kb + 128 * NSTR;
    const int et = wid >> 1, lo = (fq * 8 + (fr >> 2)) * NSTR + (fr & 3) * 4;
#pragma unroll
    for (int dd = 0; dd < 2; ++dd) { const int dt = (wid & 1) * 2 + dd; f32x4 af = {0.f, 0.f, 0.f, 0.f}, ab = {0.f, 0.f, 0.f, 0.f};
#pragma unroll
        for (int js = 0; js < 4; ++js) { const int ro = js * 32 * NSTR + lo;
            const bf16x8 A = tr8(V + ro + et * 16), Bf = tr8(Kf + ro + dt * 16), Bb = tr8(Kb + ro + dt * 16);
            af = mfma16(A, Bf, af); ab = mfma16(A, Bb, ab); }
        bf16_t* o = kv + (size_t)item * 2 * 4096 + (et * 16 + fq * 4) * 64 + dt * 16 + fr;
#pragma unroll
        for (int x = 0; x < 4; ++x) { o[x * 64] = f2bf(af[x]); o[4096 + x * 64] = f2bf(ab[x]); } }
}
__device__ __forceinline__ void ret_c_store(const RetRegs& R, bf16_t* lds, int tid) {
    const int j = tid >> 2, ds = tid & 3;
    bf16_t* Qr = lds; bf16_t* Kr = Qr + 128 * NSTR; bf16_t* V = Kr + 128 * NSTR;
    u32x4 q1, q2, k1, k2, d1, d2; rope8(R.qlo, R.qhi, R.cs, 1.0f, 1.0f, q1, q2, d1, d2); rope8(R.klo, R.khi, R.cs, 0.125f, 0.125f, k1, k2, d1, d2);
    *(u32x4*)(Qr + j * NSTR + ds * 8) = q1; *(u32x4*)(Qr + j * NSTR + 32 + ds * 8) = q2;
    *(u32x4*)(Kr + j * NSTR + ds * 8) = k1; *(u32x4*)(Kr + j * NSTR + 32 + ds * 8) = k2;
    *(u32x4*)(V + j * NSTR + ds * 16) = R.v0; *(u32x4*)(V + j * NSTR + ds * 16 + 8) = R.v1;
}
__device__ __forceinline__ void ret_c_compute(const bf16_t* proj, const bf16_t* st, const float* gnw, bf16_t* y, const bf16_t* lds, int item, int tid) {
    const int wid = tid >> 6, lane = tid & 63, fr = lane & 15, fq = lane >> 4;
    const int n = item & 31, h = (item >> 5) % 6, b = item / 192; const float l2g = log2gamma(h);
    const bf16_t* Qr = lds; const bf16_t* Kr = Qr + 128 * NSTR; const bf16_t* V = Kr + 128 * NSTR;
    const int it = wid, il = it * 16 + fr;
    const bf16x8 Qb0 = *(const bf16x8*)(Qr + il * NSTR + fq * 8), Qb1 = *(const bf16x8*)(Qr + il * NSTR + 32 + fq * 8);
    f32x4 ot[4];
#pragma unroll
    for (int et = 0; et < 4; ++et) ot[et] = (f32x4){0.f, 0.f, 0.f, 0.f};
    const int lo = (fq * 8 + (fr >> 2)) * NSTR + (fr & 3) * 4;
#pragma unroll
    for (int jg = 0; jg < 4; ++jg) { float pv[8];
#pragma unroll
        for (int t = 0; t < 2; ++t) { const int jrow = jg * 32 + (fr >> 2) * 8 + 4 * t + (fr & 3);
            const bf16x8 A0 = *(const bf16x8*)(Kr + jrow * NSTR + fq * 8), A1 = *(const bf16x8*)(Kr + jrow * NSTR + 32 + fq * 8);
            f32x4 s = {0.f, 0.f, 0.f, 0.f}; s = mfma16(A0, Qb0, s); s = mfma16(A1, Qb1, s);
#pragma unroll
            for (int e = 0; e < 4; ++e) { const int jj = jg * 32 + fq * 8 + 4 * t + e; const int dist = il > jj ? il - jj : jj - il;
                pv[t * 4 + e] = s[e] * __builtin_amdgcn_exp2f((float)dist * l2g); } }
        u32x4 pw; pw.x = pk(pv[0], pv[1]); pw.y = pk(pv[2], pv[3]); pw.z = pk(pv[4], pv[5]); pw.w = pk(pv[6], pv[7]); const bf16x8 pf = as_frag(pw);
#pragma unroll
        for (int et = 0; et < 4; ++et) { const bf16x8 vf = tr8(V + jg * 32 * NSTR + lo + et * 16); ot[et] = mfma16(vf, pf, ot[et]); } }
    const bf16_t* stf = st + (size_t)item * 2 * 4096; const bf16_t* stb = stf + 4096;
    const float wfi = __builtin_amdgcn_exp2f((float)(il + 1) * l2g), wbi = __builtin_amdgcn_exp2f((float)(128 - il) * l2g);
    float sum = 0.f;
#pragma unroll
    for (int et = 0; et < 4; ++et) { f32x4 af = {0.f, 0.f, 0.f, 0.f}, ab = {0.f, 0.f, 0.f, 0.f};
        const bf16_t* pf0 = stf + (et * 16 + fr) * 64 + fq * 8; const bf16_t* pb0 = stb + (et * 16 + fr) * 64 + fq * 8;
        af = mfma16(*(const bf16x8*)pf0, Qb0, af); af = mfma16(*(const bf16x8*)(pf0 + 32), Qb1, af);
        ab = mfma16(*(const bf16x8*)pb0, Qb0, ab); ab = mfma16(*(const bf16x8*)(pb0 + 32), Qb1, ab);
        ot[et] = ot[et] + af * wfi + ab * wbi; sum += (ot[et][0] + ot[et][1]) + (ot[et][2] + ot[et][3]); }
    sum += __shfl_xor(sum, 16); sum += __shfl_xor(sum, 32);
    const float mu = sum * (1.0f / 64.0f); float q = 0.f;
#pragma unroll
    for (int et = 0; et < 4; ++et) { ot[et] = ot[et] - mu; q += (ot[et][0] * ot[et][0] + ot[et][1] * ot[et][1]) + (ot[et][2] * ot[et][2] + ot[et][3] * ot[et][3]); }
    q += __shfl_xor(q, 16); q += __shfl_xor(q, 32);
    const float rstd = rsqrtf(q * (1.0f / 64.0f) + 1e-6f);
    const size_t tok = (size_t)b * 4096 + n * 128 + il;
    const bf16_t* gp = proj + tok * 3072 + 1920 + h * 64 + fq * 4; bf16_t* yp = y + tok * 1024 + 384 + h * 64 + fq * 4; const float* gw = gnw + h * 64 + fq * 4;
#pragma unroll
    for (int et = 0; et < 4; ++et) { const u32x2 gv = *(const u32x2*)(gp + et * 16); const f32x4 w4 = *(const f32x4*)(gw + et * 16);
        const float g0 = bflo(gv.x), g1 = bfhi(gv.x), g2 = bflo(gv.y), g3 = bfhi(gv.y);
        const float o0 = ot[et][0] * rstd * w4[0] * (g0 * sigm(g0)), o1 = ot[et][1] * rstd * w4[1] * (g1 * sigm(g1));
        const float o2 = ot[et][2] * rstd * w4[2] * (g2 * sigm(g2)), o3 = ot[et][3] * rstd * w4[3] * (g3 * sigm(g3));
        u32x2 w; w.x = pk(o0, o1); w.y = pk(o2, o3); *(u32x2*)(yp + et * 16) = w; }
}

template <bool FINAL>
__device__ void lru_item(const Params& p, int l, int item, int lane, const bf16_t* Wl, const bf16_t* Xl, int chl) {
    const int g = item % 6, ch = (item / 6) & 127, b = item / 768, fr = lane & 15, fq = lane >> 4;
    const bf16_t* proj = (const bf16_t*)(p.ws + WS_R1);
    const float* cw = p.in[2] + l * 4 * 384; const float* cb = p.in[3] + l * 384;
    const int t0 = ch * 32;
    bf16x8 A[2][2];
#pragma unroll
    for (int ks = 0; ks < 2; ++ks) { const int c = g * 64 + ks * 32 + fq * 8; float w[4][8], bias[8];
#pragma unroll
        for (int tap = 0; tap < 4; ++tap) { const float4 w0 = *(const float4*)(cw + tap * 384 + c), w1 = *(const float4*)(cw + tap * 384 + c + 4);
            w[tap][0] = w0.x; w[tap][1] = w0.y; w[tap][2] = w0.z; w[tap][3] = w0.w; w[tap][4] = w1.x; w[tap][5] = w1.y; w[tap][6] = w1.z; w[tap][7] = w1.w; }
        { const float4 b0 = *(const float4*)(cb + c), b1 = *(const float4*)(cb + c + 4);
          bias[0] = b0.x; bias[1] = b0.y; bias[2] = b0.z; bias[3] = b0.w; bias[4] = b1.x; bias[5] = b1.y; bias[6] = b1.z; bias[7] = b1.w; }
#pragma unroll
        for (int tt = 0; tt < 2; ++tt) { const int t = t0 + tt * 16 + fr; float acc[8];
#pragma unroll
            for (int jj = 0; jj < 8; ++jj) acc[jj] = bias[jj];
#pragma unroll
            for (int tap = 0; tap < 4; ++tap) { const u32x4 v = *(const u32x4*)(Xl + (chl * 32 + tt * 16 + fr + tap) * NSTR + ks * 32 + fq * 8);
#pragma unroll
                for (int jj = 0; jj < 8; ++jj) acc[jj] += BFEL(v, jj) * w[tap][jj]; }
            u32x4 pw; pw.x = pk(acc[0], acc[1]); pw.y = pk(acc[2], acc[3]); pw.z = pk(acc[4], acc[5]); pw.w = pk(acc[6], acc[7]); A[tt][ks] = as_frag(pw); } }
#pragma unroll 1
    for (int ot = 0; ot < 4; ++ot) {
        const int o = ot * 16 + fr, cgi = g * 64 + o;
        int tokb = b * 4096 + t0 + fq * 4; unsigned gtv[2][4];
        if (FINAL) { asm volatile("" : "+v"(tokb));
#pragma unroll
            for (int tt = 0; tt < 2; ++tt)
#pragma unroll
                for (int e = 0; e < 4; ++e) gtv[tt][e] = (unsigned)proj[(unsigned)(tokb + tt * 16 + e) * 3072u + 384u + (unsigned)cgi]; }
        f32x4 xcC[2];
        { u32x4 i0, i1;
#pragma unroll
          for (int dw = 0; dw < 4; ++dw) { const int m0 = o - fq * 8, m1 = o - 32 - fq * 8;
              i0[dw] = (m0 == 2 * dw ? 0x3F80u : 0u) | (m0 == 2 * dw + 1 ? 0x3F800000u : 0u);
              i1[dw] = (m1 == 2 * dw ? 0x3F80u : 0u) | (m1 == 2 * dw + 1 ? 0x3F800000u : 0u); }
          const bf16x8 I0 = as_frag(i0), I1 = as_frag(i1);
#pragma unroll
          for (int tt = 0; tt < 2; ++tt) { f32x4 a = {0.f, 0.f, 0.f, 0.f}; a = mfma16(A[tt][0], I0, a); a = mfma16(A[tt][1], I1, a); xcC[tt] = a; } }
        float hs[2][4];
#pragma unroll
        for (int tt = 0; tt < 2; ++tt)
#pragma unroll
            for (int e = 0; e < 4; ++e) hs[tt][e] = 0.f;
#pragma unroll
        for (int dir = 0; dir < 2; ++dir) {
            const bf16_t* wa = Wl + ((dir * 2 + 0) * 64 + o) * NSTR + fq * 8; const bf16_t* wx = wa + 64 * NSTR;
            const bf16x8 Ba0 = *(const bf16x8*)wa, Ba1 = *(const bf16x8*)(wa + 32), Bx0 = *(const bf16x8*)wx, Bx1 = *(const bf16x8*)(wx + 32);
            const int pi = (l * 2 + dir) * 384 + cgi;
            const float4 lc4 = ((const float4*)(p.ws + WS_LRUC))[pi];
            const float cr = lc4.x, nba = lc4.y, nbx = lc4.z;
            const size_t aidx = ((size_t)(b * 128 + ch) * 2 + dir) * 384 + cgi;
            float Hc = 0.f, Acc = 1.f;
            if (FINAL) Hc = ((const float*)(p.ws + WS_CARRY))[aidx];
#pragma unroll
            for (int step = 0; step < 2; ++step) { const int tt = dir ? 1 - step : step;
                f32x4 pa = {0.f, 0.f, 0.f, 0.f}, px = {0.f, 0.f, 0.f, 0.f};
                pa = mfma16(A[tt][0], Ba0, pa); pa = mfma16(A[tt][1], Ba1, pa); px = mfma16(A[tt][0], Bx0, px); px = mfma16(A[tt][1], Bx1, px);
                float av[4], uv[4];
#pragma unroll
                for (int e = 0; e < 4; ++e) { const float r = __builtin_amdgcn_rcpf(1.0f + __builtin_amdgcn_exp2f(fmaf(pa[e], -LOG2E, nba)));
                    const float ii = __builtin_amdgcn_rcpf(1.0f + __builtin_amdgcn_exp2f(fmaf(px[e], -LOG2E, nbx)));
                    const float a = __builtin_amdgcn_exp2f(cr * r); const float em = fmaxf(fmaf(-a, a, 1.0f), 0.f);
                    av[e] = a; uv[e] = __builtin_amdgcn_sqrtf(em) * ii * xcC[tt][e]; }
                float Aq, Uq;
                if (dir == 0) { Aq = av[0]; Uq = uv[0];
#pragma unroll
                    for (int e = 1; e < 4; ++e) { Uq = av[e] * Uq + uv[e]; Aq *= av[e]; } }
                else { Aq = av[3]; Uq = uv[3];
#pragma unroll
                    for (int e = 2; e >= 0; --e) { Uq = av[e] * Uq + uv[e]; Aq *= av[e]; } }
                float Aall[4], Uall[4];
#pragma unroll
                for (int q = 0; q < 4; ++q) { Aall[q] = __shfl(Aq, q * 16 + fr); Uall[q] = __shfl(Uq, q * 16 + fr); }
                float hq = Hc, hh = Hc;
#pragma unroll
                for (int qq = 0; qq < 4; ++qq) { const int q = dir ? 3 - qq : qq; const bool before = dir ? (q > fq) : (q < fq);
                    if (before) hq = Aall[q] * hq + Uall[q];
                    hh = Aall[q] * hh + Uall[q]; Acc *= Aall[q]; }
                Hc = hh;
                if (FINAL) {
                    if (dir == 0) {
#pragma unroll
                        for (int e = 0; e < 4; ++e) { hq = av[e] * hq + uv[e]; hs[tt][e] += hq; } }
                    else {
#pragma unroll
                        for (int e = 3; e >= 0; --e) { hq = av[e] * hq + uv[e]; hs[tt][e] += hq; } }
                }
            }
            if (!FINAL) { if (fq == 0) ((float2*)(p.ws + WS_AGG))[aidx] = make_float2(Acc, Hc); }
        }
        if (FINAL) { bf16_t* y = (bf16_t*)(p.ws + WS_Y);
#pragma unroll
            for (int tt = 0; tt < 2; ++tt)
#pragma unroll
                for (int e = 0; e < 4; ++e) { const unsigned tok = (unsigned)(tokb + tt * 16 + e);
                    const float gt = __uint_as_float(gtv[tt][e] << 16);
                    const float z = 0.7978845608028654f * (gt + 0.044715f * gt * gt * gt); const float th = 1.0f - 2.0f * __builtin_amdgcn_rcpf(1.0f + __builtin_amdgcn_exp2f(2.885390081777927f * z));
                    y[tok * 1024u + (unsigned)cgi] = f2bf(hs[tt][e] * 0.5f * gt * (1.0f + th)); } }
    }
}

__device__ __forceinline__ void lru_stage_w(const Params& p, int l, int g, bf16_t* Wl, int tid) {
    const bf16_t* lw = (const bf16_t*)(p.ws + WS_LRUW);
#pragma unroll
    for (int i = 0; i < 4; ++i) { const int idx = tid + 512 * i, mat = idx >> 9, o = (idx >> 3) & 63, c8 = idx & 7;
        const u32x4 v = *(const u32x4*)(lw + (size_t)(((l * 2 + (mat >> 1)) * 2 + (mat & 1)) * 6 + g) * 4096 + o * 64 + c8 * 8);
        *(u32x4*)(Wl + (mat * 64 + o) * NSTR + c8 * 8) = v; }
}
struct LruX { u32x4 v[5]; };
__device__ __forceinline__ void lru_xload(LruX& R, const Params& p, int T, int tid) {
    const bf16_t* proj = (const bf16_t*)(p.ws + WS_R1);
    const int g = T % 6, rest = T / 6, b = rest >> 4, tb = (rest & 15) * 256 - 2;
#pragma unroll
    for (int i = 0; i < 5; ++i) { const int idx = tid + 512 * i, row = idx >> 3, c8 = idx & 7, tok = tb + row; R.v[i] = (u32x4){0u, 0u, 0u, 0u};
        if (row < 259 && tok >= 0 && tok < SEQ) R.v[i] = *(const u32x4*)(proj + ((size_t)b * 4096 + tok) * 3072 + g * 64 + c8 * 8); }
}
__device__ __forceinline__ void lru_xstore(const LruX& R, bf16_t* Xl, int tid) {
#pragma unroll
    for (int i = 0; i < 5; ++i) { const int idx = tid + 512 * i, row = idx >> 3, c8 = idx & 7; if (row < 259) *(u32x4*)(Xl + row * NSTR + c8 * 8) = R.v[i]; }
}
__device__ void phase_mix_a(const Params& p, int l, unsigned char* ldsg) {
    const int tid = tidx(), nb = gridDim.x, rb_ = bidx(), bid = (nb % 8 == 0) ? (rb_ & 7) * (nb >> 3) + (rb_ >> 3) : rb_;
    const bf16_t* proj = (const bf16_t*)(p.ws + WS_R1);
    float* rp = (float*)(ldsg + 83968);
    { const float* src = p.in[10] + l * 1860; for (int i = tid; i < 1860; i += 512) rp[i] = src[i]; }
    { NatRegs R; int t = bid; if (t < 1024) nat_load(R, proj, t, tid);
      for (; t < 1024; t += nb) { nat_store(R, (bf16_t*)ldsg, t, tid); __syncthreads();
          const int tn = t + nb; if (tn < 1024) nat_load(R, proj, tn, tid);
          nat_compute(proj, (bf16_t*)(p.ws + WS_Y), (const bf16_t*)ldsg, rp, t, tid); __syncthreads(); } }
    { RetRegs R; int t = bid; const float2* rope = (const float2*)(p.ws + WS_ROPE); if (t < 1536) ret_load<false>(R, proj, rope, t, tid);
      for (; t < 1536; t += nb) { ret_a_store(R, (bf16_t*)ldsg, t, tid); __syncthreads();
          const int tn = t + nb; if (tn < 1536) ret_load<false>(R, proj, rope, tn, tid);
          ret_a_compute((bf16_t*)(p.ws + WS_KV), (const bf16_t*)ldsg, t, tid); __syncthreads(); } }
    { LruX XR; int t = bid; if (t < 768) lru_xload(XR, p, t, tid);
      for (; t < 768; t += nb) {
        const int g = t % 6, rest = t / 6, b = rest >> 4, ch = (rest & 15) * 8 + (tid >> 6);
        lru_stage_w(p, l, g, (bf16_t*)ldsg, tid); lru_xstore(XR, (bf16_t*)(ldsg + 40192), tid); __syncthreads();
        if (t + nb < 768) lru_xload(XR, p, t + nb, tid);
        lru_item<false>(p, l, (b * 128 + ch) * 6 + g, tid & 63, (const bf16_t*)ldsg, (const bf16_t*)(ldsg + 40192), tid >> 6); __syncthreads(); } }
}
__device__ void phase_mix_b(const Params& p, unsigned char* ldsg) {
    const int tid = tidx(), nb = gridDim.x, bid = bidx();
    for (int t = bid; t < 816; t += nb) {
        if (t >= 48) { const int u = t - 48;
            const int dir = u & 1, blk = (u >> 1) & 7, bh = u >> 4; const int h = bh % 6; const int el = blk * 512 + tid;
            const float gch = exp2f(128.0f * log2gamma(h));
            const bf16_t* kv = (const bf16_t*)(p.ws + WS_KV) + ((size_t)bh * 32 * 2 + dir) * 4096 + el; bf16_t* st = (bf16_t*)(p.ws + WS_ST) + ((size_t)bh * 32 * 2 + dir) * 4096 + el;
            float s = 0.f;
            if (dir == 0) {
#pragma unroll
                for (int n = 0; n < 32; ++n) { st[(size_t)n * 8192] = f2bf(s); s = gch * s + __uint_as_float(((unsigned)kv[(size_t)n * 8192]) << 16); } }
            else {
#pragma unroll
                for (int n = 31; n >= 0; --n) { st[(size_t)n * 8192] = f2bf(s); s = gch * s + __uint_as_float(((unsigned)kv[(size_t)n * 8192]) << 16); } }
        } else {
            const int seg = tid >> 7, sq = t * 128 + (tid & 127), c = sq % 384, dir = (sq / 384) & 1, b = sq / 768;
            const float2* agg = (const float2*)(p.ws + WS_AGG); float* carry = (float*)(p.ws + WS_CARRY); float2* xs = (float2*)ldsg;
            float2 au[32];
#pragma unroll
            for (int k = 0; k < 32; ++k) { const int pos = seg * 32 + k, ch = dir ? 127 - pos : pos; au[k] = agg[((size_t)(b * 128 + ch) * 2 + dir) * 384 + c]; }
            float As = 1.f, Us = 0.f;
#pragma unroll
            for (int k = 0; k < 32; ++k) { Us = au[k].x * Us + au[k].y; As *= au[k].x; }
            xs[seg * 128 + (tid & 127)] = make_float2(As, Us);
            __syncthreads();
            float hcur = 0.f;
#pragma unroll
            for (int s2 = 0; s2 < 3; ++s2) if (s2 < seg) { const float2 e = xs[s2 * 128 + (tid & 127)]; hcur = e.x * hcur + e.y; }
#pragma unroll
            for (int k = 0; k < 32; ++k) { const int pos = seg * 32 + k, ch = dir ? 127 - pos : pos; carry[((size_t)(b * 128 + ch) * 2 + dir) * 384 + c] = hcur; hcur = au[k].x * hcur + au[k].y; }
            __syncthreads();
        }
    }
}
__device__ void phase_mix_c(const Params& p, int l, unsigned char* ldsg) {
    const int tid = tidx(), nb = gridDim.x, rb_ = bidx(), bid = (nb % 8 == 0) ? (rb_ & 7) * (nb >> 3) + (rb_ >> 3) : rb_;
    const bf16_t* proj = (const bf16_t*)(p.ws + WS_R1);
    { RetRegs R; int t = bid; const float2* rope = (const float2*)(p.ws + WS_ROPE); if (t < 1536) ret_load<true>(R, proj, rope, t, tid);
      for (; t < 1536; t += nb) { ret_c_store(R, (bf16_t*)ldsg, tid); __syncthreads();
          const int tn = t + nb; if (tn < 1536) ret_load<true>(R, proj, rope, tn, tid);
          ret_c_compute(proj, (const bf16_t*)(p.ws + WS_ST), p.in[9] + l * 384, (bf16_t*)(p.ws + WS_Y), (const bf16_t*)ldsg, t, tid); __syncthreads(); } }
    { LruX XR; int t = bid; if (t < 768) lru_xload(XR, p, t, tid);
      for (; t < 768; t += nb) {
        const int g = t % 6, rest = t / 6, b = rest >> 4, ch = (rest & 15) * 8 + (tid >> 6);
        lru_stage_w(p, l, g, (bf16_t*)ldsg, tid); lru_xstore(XR, (bf16_t*)(ldsg + 40192), tid); __syncthreads();
        if (t + nb < 768) lru_xload(XR, p, t + nb, tid);
        lru_item<true>(p, l, (b * 128 + ch) * 6 + g, tid & 63, (const bf16_t*)ldsg, (const bf16_t*)(ldsg + 40192), tid >> 6); __syncthreads(); } }
}

__device__ void run_phase(int ph, unsigned char* ldsg, LAS unsigned char* lds) {
    const Params __attribute__((address_space(4)))* kp = (const Params __attribute__((address_space(4)))*)__builtin_amdgcn_kernarg_segment_ptr();
    asm volatile("" : "+s"(kp));
    const Params& p = *(const Params*)kp;
    unsigned char* ws = p.ws;
    if (ph == 0) { phase_init(p, ldsg); return; }
    const int l = (ph - 1) / 9, s = (ph - 1) % 9;
    const int GBID = bidx();
    pg8::StaticOrder S;
    if (s == 0) { pg8::Gemm g{(const bf16_t*)(ws + WS_XB), (const bf16_t*)(ws + WS_WIN) + (size_t)l * 3072 * 1024, MTOK, 3072, 1024};
        S.init(MTOK, 3072, gridDim.x, GBID);
        EpiProj E{(bf16_t*)(ws + WS_R1), 3072}; pg8::gemm_phase<EpiProj, pg8::StaticOrder>(lds, g, S, E, nullptr); }
    else if (s == 1) phase_mix_a(p, l, ldsg);
    else if (s == 2) phase_mix_b(p, ldsg);
    else if (s == 3) phase_mix_c(p, l, ldsg);
    else if (s == 4) { pg8::Gemm g{(const bf16_t*)(ws + WS_Y), (const bf16_t*)(ws + WS_WOUT) + (size_t)l * 1024 * 1024, MTOK, 1024, 1024};
        S.init(MTOK, 1024, gridDim.x, GBID); EpiProj E{(bf16_t*)(ws + WS_XB), 1024}; pg8::gemm_phase<EpiProj, pg8::StaticOrder>(lds, g, S, E, nullptr); }
    else if (s == 5) phase_ln(l == 0 ? p.in[0] : p.out, (const bf16_t*)(ws + WS_XB), p.in[12] + l * 1024, p.in[13] + l * 1024, p.out, (bf16_t*)(ws + WS_XB));
    else if (s == 6) { pg8::Gemm g{(const bf16_t*)(ws + WS_XB), (const bf16_t*)(ws + WS_WGU) + (size_t)l * 5632 * 1024, MTOK, 5632, 1024};
        S.init(MTOK, 5632, gridDim.x, GBID);
        EpiSwiglu E{(bf16_t*)(ws + WS_R1)}; pg8::gemm_phase<EpiSwiglu, pg8::StaticOrder>(lds, g, S, E, nullptr); }
    else if (s == 7) { pg8::Gemm g{(const bf16_t*)(ws + WS_R1), (const bf16_t*)(ws + WS_WD) + (size_t)l * 1024 * 2816, MTOK, 1024, 2816};
        S.init(MTOK, 1024, gridDim.x, GBID); EpiProj E{(bf16_t*)(ws + WS_XB), 1024}; pg8::gemm_phase<EpiProj, pg8::StaticOrder>(lds, g, S, E, nullptr); }
    else if (s == 8) phase_ln(p.out, (const bf16_t*)(ws + WS_XB), p.in[17] + l * 1024, p.in[18] + l * 1024, p.out, l == NL - 1 ? nullptr : (bf16_t*)(ws + WS_XB));
}

#define XB_TMO      128
#define XB_XCNT(j)  (256  + 64 * (j))
#define XB_XSUB(j)  (1280 + 64 * (j))
#define XB_XGEN(j)  (2304 + 64 * (j))
#define XB_TOP      3328
#define XB_TOPGEN   3392
#define XCD_BAR_WORDS 3456
#define XB_SPIN_CAP (1u << 18)
__device__ __forceinline__ unsigned xb_ld(unsigned* p)              { return __hip_atomic_load(p, __ATOMIC_RELAXED, __HIP_MEMORY_SCOPE_AGENT); }
__device__ __forceinline__ unsigned xb_add(unsigned* p, unsigned v) { return __hip_atomic_fetch_add(p, v, __ATOMIC_RELAXED, __HIP_MEMORY_SCOPE_AGENT); }
__device__ __forceinline__ unsigned xb_xcc_id() { return (unsigned)__builtin_amdgcn_s_getreg((3 << 11) | 20) & 0xFu; }
#define XB_SPIN(cond, bar) do { unsigned _sp = 0; while (cond) { __builtin_amdgcn_s_sleep(1); \
    if ((++_sp & 255u) == 0u) { if (xb_ld(&(bar)[XB_TMO])) break; if (_sp > XB_SPIN_CAP) { atomicAdd(&(bar)[XB_TMO], 1u); break; } } } } while (0)
struct XcdBarrier { unsigned* bar; unsigned x; volatile LAS unsigned* st; };
__device__ __forceinline__ XcdBarrier xcd_barrier_post(unsigned* bar, volatile LAS unsigned* st) {
    XcdBarrier b; b.bar = bar; b.x = xb_xcc_id(); b.st = st;
    if (threadIdx.x == 0) (void)xb_add(&bar[XB_XCNT(b.x)], 1u);
    return b;
}
__device__ __forceinline__ void xcd_barrier_complete(unsigned* bar, unsigned x, unsigned& nloc, unsigned& nx) {
    const unsigned G = gridDim.x * gridDim.y * gridDim.z;
    unsigned sum, cnt, mine, sp = 0u;
    for (;;) {
        sum = 0u; cnt = 0u; mine = 0u;
#pragma unroll
        for (unsigned j = 0; j < 16; ++j) { const unsigned c = xb_ld(&bar[XB_XCNT(j)]); sum += c; cnt += (c > 0u) ? 1u : 0u; mine = (j == x) ? c : mine; }
        if (sum == G) break;
        __builtin_amdgcn_s_sleep(1);
        if ((++sp & 255u) == 0u) { if (xb_ld(&bar[XB_TMO])) break; if (sp > XB_SPIN_CAP) { atomicAdd(&bar[XB_TMO], 1u); break; } }
    }
    nloc = mine > 0u ? mine : 1u; nx = cnt > 0u ? cnt : 1u;
}
__device__ __forceinline__ void xcd_barrier(const XcdBarrier& b) {
    asm volatile("s_waitcnt vmcnt(0)" ::: "memory");
    __syncthreads();
    if (threadIdx.x == 0) {
        unsigned* bar = b.bar;
        __builtin_amdgcn_s_waitcnt(0);
        unsigned nloc = b.st[0], nx = b.st[1];
        if (nloc == 0u) { xcd_barrier_complete(bar, b.x, nloc, nx); b.st[0] = nloc; b.st[1] = nx; }
        const unsigned old = xb_add(&bar[XB_XSUB(b.x)], 1u);
        const unsigned gen = old / nloc;
        if (old + 1u == (gen + 1u) * nloc) {
            __builtin_amdgcn_fence(__ATOMIC_RELEASE, "agent");
            asm volatile("s_waitcnt vmcnt(0)" ::: "memory");
            const unsigned og = xb_add(&bar[XB_TOP], 1u);
            const unsigned tg = og / nx;
            if (og + 1u == (tg + 1u) * nx) xb_add(&bar[XB_TOPGEN], 1u);
            else XB_SPIN(xb_ld(&bar[XB_TOPGEN]) == tg, bar);
            __builtin_amdgcn_fence(__ATOMIC_ACQUIRE, "agent");
            xb_add(&bar[XB_XGEN(b.x)], 1u);
            asm volatile("s_waitcnt vmcnt(0)" ::: "memory");
        } else {
            XB_SPIN(xb_ld(&bar[XB_XGEN(b.x)]) == gen, bar);
            __builtin_amdgcn_fence(__ATOMIC_ACQUIRE, "agent");
            asm volatile("s_waitcnt vmcnt(0)" ::: "memory");
        }
    }
    __syncthreads();
}

__global__ void __launch_bounds__(512) fwd_mega(Params p) {
    extern __shared__ __attribute__((aligned(16))) unsigned char ldsg[];
    LAS unsigned char* lds = (LAS unsigned char*)ldsg;
    cg::grid_group grid = cg::this_grid();
    volatile LAS unsigned* stw = (volatile LAS unsigned*)(lds + 131072);
    XcdBarrier xbar; xbar.bar = (unsigned*)(p.ws + WS_BAR); xbar.x = 0; xbar.st = stw;
    if (p.coop) { if (threadIdx.x == 0) { stw[0] = 0u; stw[1] = 0u; } __syncthreads(); xbar = xcd_barrier_post((unsigned*)(p.ws + WS_BAR), stw); }
    int nsync = 0;
    for (int ph = p.ph_lo; ph < p.ph_hi; ++ph) {
        run_phase(ph, ldsg, lds);
        if (p.coop && ph + 1 < p.ph_hi) { if (nsync == 0) grid.sync(); else xcd_barrier(xbar); ++nsync; }
    }
}

#ifndef N_LAUNCH_MODE
#define N_LAUNCH_MODE 1
#endif
extern "C" void kernel_launch(void* const* d_in, const int* in_sizes, int n_in, void* d_out, int out_size, void* d_ws, size_t ws_size, hipStream_t stream) {
    static int grid = 0;
    if (grid == 0) {
        int dev = 0, cus = 0, per_cu = 0;
        hipGetDevice(&dev); hipDeviceGetAttribute(&cus, hipDeviceAttributeMultiprocessorCount, dev);
        hipFuncSetAttribute((const void*)fwd_mega, hipFuncAttributeMaxDynamicSharedMemorySize, LDS_BYTES);
        hipOccupancyMaxActiveBlocksPerMultiprocessor(&per_cu, (const void*)fwd_mega, 512, LDS_BYTES);
        (void)hipGetLastError();
        if (per_cu < 1) per_cu = 1;
        grid = cus * 1;
        if (ws_size < WS_END) fprintf(stderr, "kernel_launch: workspace too small: %zu < %zu\n", ws_size, (size_t)WS_END);
    }
    Params p{};
    for (int i = 0; i < 19; ++i) p.in[i] = (const float*)d_in[i];
    p.out = (float*)d_out; p.ws = (unsigned char*)d_ws;
#if N_LAUNCH_MODE == 1
    p.ph_lo = 0; p.ph_hi = NPHASE; p.coop = 1;
    (void)hipMemsetAsync((unsigned char*)d_ws + WS_BAR, 0, XCD_BAR_BYTES, stream);
    void* args[] = {&p};
    hipError_t e = hipLaunchCooperativeKernel((const void*)fwd_mega, dim3(grid), dim3(512), args, LDS_BYTES, stream);
    if (e != hipSuccess) fprintf(stderr, "cooperative launch failed: %s (grid %d)\n", hipGetErrorString(e), grid);
#else
    for (int ph = 0; ph < NPHASE; ++ph) { p.ph_lo = ph; p.ph_hi = ph + 1; p.coop = 0;
        hipLaunchKernelGGL(fwd_mega, dim3(grid), dim3(512), LDS_BYTES, stream, p); }
#endif
}
```
